# Optimizing an MI355X kernel written in HIP

```python
import jax
import jax.numpy as jnp
from jax import lax
import numpy as np

D_MODEL = 1024
BATCH = 8
SEQ = 4096
DEPTH = 2

GRID_W = 64
CTX_LEN = 256
CHUNK = 128
A_GROUP_DIM = 128
A_GROUPS = D_MODEL // A_GROUP_DIM
D_A = A_GROUPS * A_GROUP_DIM
R_HEADS = 4
R_QK_DIM = D_MODEL // 8
R_V_DIM = D_MODEL // 4
D_RQK = R_HEADS * R_QK_DIM
D_RV = R_HEADS * R_V_DIM
D_IN = 2 * D_A + 2 * D_RQK + 2 * D_RV + 2 * D_MODEL
KV_START = 2 * D_A + D_RQK
KV_END = KV_START + D_RQK + D_RV
ROPE_BASE = 10000.0
MOE_GROUPS = 4
EXPERTS_PER_GROUP = 8
N_EXPERTS = MOE_GROUPS * EXPERTS_PER_GROUP
TOP_K = 2
EXPERT_FF = D_MODEL // 2
MOE_BLOCK = 128
EPS = 1e-6

kernel_name = 'hybrid_sgu_retention_hmoe_dit'


def rmsnorm(x, g):
    xf = x.astype(jnp.float32)
    y = xf * lax.rsqrt(jnp.mean(xf * xf, axis=-1, keepdims=True) + EPS)
    return (y * g.astype(jnp.float32)).astype(x.dtype)


def layernorm(x):
    xf = x.astype(jnp.float32)
    mu = jnp.mean(xf, axis=-1, keepdims=True)
    var = jnp.mean(jnp.square(xf - mu), axis=-1, keepdims=True)
    return ((xf - mu) * lax.rsqrt(var + EPS)).astype(x.dtype)


def adaln(cond, w_ada, b_ada):
    m = jax.nn.silu(cond) @ w_ada + b_ada
    return jnp.split(m[..., None, :], 6, axis=-1)


def modulate(h, shift, scale):
    return h * (1.0 + scale) + shift


def to_heads(t, n_heads):
    b, n, _ = t.shape
    return t.reshape(b, n, n_heads, -1).transpose(0, 2, 1, 3)


def grid_rotary(rows):
    n_freq = R_QK_DIM // 4
    inv = ROPE_BASE ** (-jnp.arange(n_freq, dtype=jnp.float32) / n_freq)
    row = jnp.repeat(jnp.arange(rows, dtype=jnp.float32), GRID_W)
    col = jnp.tile(jnp.arange(GRID_W, dtype=jnp.float32), rows)
    ang = jnp.concatenate([row[:, None] * inv, col[:, None] * inv], axis=-1)
    return jnp.cos(ang), jnp.sin(ang)


def apply_rotary(t, cos, sin):
    t1, t2 = t[..., 0::2], t[..., 1::2]
    r = jnp.stack([t1 * cos - t2 * sin, t1 * sin + t2 * cos], axis=-1)
    return r.reshape(t.shape).astype(t.dtype)


def retention_direction(q, k, v, log_g, s0, inclusive):
    b, h, n, dk = q.shape
    dv = v.shape[-1]
    nc = n // CHUNK
    qc = q.reshape(b, h, nc, CHUNK, dk)
    kc = k.reshape(b, h, nc, CHUNK, dk)
    vc = v.reshape(b, h, nc, CHUNK, dv)
    j = jnp.arange(CHUNK, dtype=jnp.float32)
    diff = j[:, None] - j[None, :]
    keep = (diff >= 0) if inclusive else (diff > 0)
    d_intra = jnp.where(keep[None], jnp.exp(log_g[:, None, None] * jnp.maximum(diff, 0.0)[None]), 0.0)
    q_dec = jnp.exp(log_g[:, None] * (j + 1.0))
    k_dec = jnp.exp(log_g[:, None] * (CHUNK - 1.0 - j))
    c_dec = jnp.exp(log_g * CHUNK)[None, :, None, None]
    scores = jnp.einsum('bhncd,bhnmd->bhncm', qc, kc) * d_intra[None, :, None]
    intra = jnp.einsum('bhncm,bhnme->bhnce', scores, vc)
    kv = jnp.einsum('bhncd,bhnce->nbhde', kc * k_dec[None, :, None, :, None], vc)

    def step(s, kv_i):
        return s * c_dec + kv_i, s

    _, s_prev = lax.scan(step, s0, kv)
    cross = jnp.einsum('bhncd,nbhde->bhnce', qc * q_dec[None, :, None, :, None], s_prev)
    return (intra + cross).reshape(b, h, n, dv)


def retention_bidirectional(q, k, v, log_gf, log_gb, s0_f, s0_b):
    flip = lambda t: jnp.flip(t, axis=2)
    o_f = retention_direction(q, k, v, log_gf, s0_f, True)
    o_b = retention_direction(flip(q), flip(k), flip(v), log_gb, s0_b, False)
    return o_f + flip(o_b)


def context_state(k, v, log_g, reverse):
    n = k.shape[2]
    m = jnp.arange(n, dtype=jnp.float32)
    expo = m if reverse else (n - 1.0) - m
    w = jnp.exp(log_g[:, None] * expo[None, :])
    return jnp.einsum('bhmd,bhme,hm->bhde', k, v, w)


def spatial_gating(u, v, w_s, b_s, g_sgu):
    b, n, _ = u.shape
    nc = n // CHUNK
    vn = (layernorm(v) * g_sgu).reshape(b, nc, CHUNK, A_GROUPS, A_GROUP_DIM)
    s = jnp.einsum('gpq,bnqgc->bnpgc', w_s, vn) + b_s.T[None, None, :, :, None]
    return u * s.reshape(b, n, D_A)


def split_projection(p):
    sizes = (D_A, D_A, D_RQK, D_RQK, D_RV, D_RV, D_MODEL, D_MODEL)
    cuts = [int(s) for s in np.cumsum(sizes)[:-1]]
    return jnp.split(p, cuts, axis=-1)


def token_mix(p, s0_f, s0_b, log_gf, log_gb, rotary, w_s, b_s, g_sgu, w_pa, w_pb, w_out):
    u, va, q, k, vr, gr, ga, gb = split_projection(p)
    y_a = spatial_gating(jax.nn.gelu(u), jax.nn.gelu(va), w_s, b_s, g_sgu)
    qh = to_heads(q, R_HEADS).astype(jnp.float32)
    kh = to_heads(k, R_HEADS).astype(jnp.float32) * (R_QK_DIM ** -0.5)
    vh = to_heads(vr, R_HEADS).astype(jnp.float32)
    if rotary is not None:
        cos, sin = rotary
        qh = apply_rotary(qh, cos, sin)
        kh = apply_rotary(kh, cos, sin)
    o = retention_bidirectional(qh, kh, vh, log_gf, log_gb, s0_f, s0_b)
    o = layernorm(o).transpose(0, 2, 1, 3).reshape(p.shape[0], p.shape[1], D_RV).astype(p.dtype)
    y_b = jax.nn.silu(gr) * o
    merged = jax.nn.sigmoid(ga) * (y_a @ w_pa) + jax.nn.sigmoid(gb) * (y_b @ w_pb)
    return merged @ w_out


def expert_dispatch(h, expert_id, weights, w1, w3, w2):
    t, d = h.shape
    a = t * TOP_K
    e_flat = expert_id.reshape(a)
    tok_flat = jnp.repeat(jnp.arange(t, dtype=jnp.int32), TOP_K)
    w_flat = weights.reshape(a)
    order = jnp.argsort(e_flat)
    e_sorted, tok_sorted, w_sorted = e_flat[order], tok_flat[order], w_flat[order]
    counts = jnp.bincount(e_flat, length=N_EXPERTS)
    padded = (counts + MOE_BLOCK - 1) // MOE_BLOCK * MOE_BLOCK
    start = jnp.cumsum(counts) - counts
    pend = jnp.cumsum(padded)
    dest = (pend - padded)[e_sorted] + (jnp.arange(a) - start[e_sorted])
    n_blocks = (a + N_EXPERTS * (MOE_BLOCK - 1) + MOE_BLOCK - 1) // MOE_BLOCK
    p = n_blocks * MOE_BLOCK
    buf_tok = jnp.full((p,), t, dtype=jnp.int32).at[dest].set(tok_sorted)
    buf_w = jnp.zeros((p,), h.dtype).at[dest].set(w_sorted.astype(h.dtype))
    blk_e = jnp.minimum(jnp.searchsorted(pend, jnp.arange(n_blocks) * MOE_BLOCK, side='right'), N_EXPERTS - 1)
    h_pad = jnp.concatenate([h, jnp.zeros((1, d), h.dtype)], axis=0)
    xb = h_pad[buf_tok].reshape(n_blocks, MOE_BLOCK, d)

    def expert_block(args):
        xblk, e = args
        return (jax.nn.silu(xblk @ w1[e]) * (xblk @ w3[e])) @ w2[e]

    yb = lax.map(expert_block, (xb, blk_e))
    y = yb.reshape(p, d) * buf_w[:, None]
    return jax.ops.segment_sum(y, buf_tok, num_segments=t + 1)[:t]


def hier_moe(h, w_group, b_group, w_erouter, b_erouter, w1, w3, w2):
    t = h.shape[0]
    hf = h.astype(jnp.float32)
    g_logits = hf @ w_group.astype(jnp.float32) + b_group.astype(jnp.float32)
    g_top, g_sel = lax.top_k(g_logits, 1)
    p_group = jnp.exp(g_top - jax.nn.logsumexp(g_logits, axis=-1, keepdims=True))
    e_logits = (hf @ w_erouter.astype(jnp.float32) + b_erouter.astype(jnp.float32)).reshape(t, MOE_GROUPS, EXPERTS_PER_GROUP)
    idx = jnp.broadcast_to(g_sel[:, :, None], (t, 1, EXPERTS_PER_GROUP))
    e_in_group = jnp.take_along_axis(e_logits, idx, axis=1)[:, 0]
    e_top, e_sel = lax.top_k(e_in_group, TOP_K)
    weights = p_group * jax.nn.softmax(e_top, axis=-1)
    expert_id = g_sel * EXPERTS_PER_GROUP + e_sel
    return expert_dispatch(h, expert_id, weights, w1, w3, w2)


def hybrid_layer(x, xc, c, c_ctx, w_ada, b_ada, g_mix, g_ffn, w_in, w_s, b_s, g_sgu, decay_logit,
                 w_pa, w_pb, w_out, w_group, b_group, w_erouter, b_erouter, w1, w3, w2, rotary, update_ctx):
    b, n, d = x.shape
    l_ctx = xc.shape[1]
    sh1, sc1, gt1, sh2, sc2, gt2 = adaln(c, w_ada, b_ada)
    sh1c, sc1c, gt1c, sh2c, sc2c, gt2c = adaln(c_ctx, w_ada, b_ada)
    log_g = jax.nn.log_sigmoid(decay_logit.astype(jnp.float32))
    log_gf, log_gb = log_g[0], log_g[1]
    mix_w = (w_s, b_s, g_sgu, w_pa, w_pb, w_out)
    h = modulate(rmsnorm(x, g_mix), sh1, sc1)
    hc = modulate(rmsnorm(xc, g_mix), sh1c, sc1c)
    if update_ctx:
        pc = hc @ w_in
        kv_c = pc[..., KV_START:KV_END]
    else:
        kv_c = hc @ w_in[:, KV_START:KV_END]
    kh_c = to_heads(kv_c[..., :D_RQK], R_HEADS).astype(jnp.float32) * (R_QK_DIM ** -0.5)
    vh_c = to_heads(kv_c[..., D_RQK:], R_HEADS).astype(jnp.float32)
    s_ctx_f = context_state(kh_c, vh_c, log_gf, False)
    s_ctx_b = context_state(kh_c, vh_c, log_gb, True)
    x = x + gt1 * token_mix(h @ w_in, s_ctx_f, s_ctx_b, log_gf, log_gb, rotary, *mix_w)
    if update_ctx:
        zero_state = jnp.zeros_like(s_ctx_f)
        xc = xc + gt1c * token_mix(pc, zero_state, zero_state, log_gf, log_gb, None, *mix_w)
    h2 = modulate(rmsnorm(x, g_ffn), sh2, sc2).reshape(b * n, d)
    if update_ctx:
        h2c = modulate(rmsnorm(xc, g_ffn), sh2c, sc2c).reshape(b * l_ctx, d)
        y = hier_moe(jnp.concatenate([h2, h2c], axis=0), w_group, b_group, w_erouter, b_erouter, w1, w3, w2)
        x = x + gt2 * y[:b * n].reshape(b, n, d)
        xc = xc + gt2c * y[b * n:].reshape(b, l_ctx, d)
    else:
        y = hier_moe(h2, w_group, b_group, w_erouter, b_erouter, w1, w3, w2)
        x = x + gt2 * y.reshape(b, n, d)
    return x, xc


def setup_inputs(seed: int = 0) -> dict:
    key = jax.random.key(seed)
    ks = jax.random.split(key, 24)
    f32 = jnp.float32
    d = D_MODEL

    def nrm(k, shape, s):
        return jax.random.normal(k, shape, f32) * s

    base_logit = jnp.log(2.0 ** (5.0 + jnp.arange(R_HEADS, dtype=f32)) - 1.0)
    return {
        'x': nrm(ks[0], (BATCH, SEQ, d), 1.0),
        'c': nrm(ks[1], (BATCH, d), 1.0),
        'ctx': nrm(ks[2], (BATCH, CTX_LEN, d), 1.0),
        'c_ctx': nrm(ks[3], (d,), 1.0),
        'w_ada': nrm(ks[4], (DEPTH, d, 6 * d), 0.5 * d ** -0.5),
        'b_ada': nrm(ks[5], (DEPTH, 6 * d), 0.02),
        'g_mix': 1.0 + nrm(ks[6], (DEPTH, d), 0.02),
        'g_ffn': 1.0 + nrm(ks[7], (DEPTH, d), 0.02),
        'w_in': nrm(ks[8], (DEPTH, d, D_IN), d ** -0.5),
        'w_s': nrm(ks[9], (DEPTH, A_GROUPS, CHUNK, CHUNK), CHUNK ** -0.5),
        'b_s': 1.0 + nrm(ks[10], (DEPTH, A_GROUPS, CHUNK), 0.02),
        'g_sgu': 1.0 + nrm(ks[11], (DEPTH, D_A), 0.02),
        'decay_logit': base_logit + nrm(ks[12], (DEPTH, 2, R_HEADS), 0.1),
        'w_pa': nrm(ks[13], (DEPTH, D_A, d), D_A ** -0.5),
        'w_pb': nrm(ks[14], (DEPTH, D_RV, d), D_RV ** -0.5),
        'w_out': nrm(ks[15], (DEPTH, d, d), d ** -0.5),
        'w_group': nrm(ks[16], (DEPTH, d, MOE_GROUPS), d ** -0.5),
        'b_group': nrm(ks[17], (DEPTH, MOE_GROUPS), 0.01),
        'w_erouter': nrm(ks[18], (DEPTH, d, N_EXPERTS), d ** -0.5),
        'b_erouter': nrm(ks[19], (DEPTH, N_EXPERTS), 0.01),
        'w1': nrm(ks[20], (DEPTH, N_EXPERTS, d, EXPERT_FF), d ** -0.5),
        'w3': nrm(ks[21], (DEPTH, N_EXPERTS, d, EXPERT_FF), d ** -0.5),
        'w2': nrm(ks[22], (DEPTH, N_EXPERTS, EXPERT_FF, d), EXPERT_FF ** -0.5),
        'g_final': 1.0 + nrm(ks[23], (d,), 0.02),
    }


def reference(x, c, ctx, c_ctx, w_ada, b_ada, g_mix, g_ffn, w_in, w_s, b_s, g_sgu, decay_logit,
              w_pa, w_pb, w_out, w_group, b_group, w_erouter, b_erouter, w1, w3, w2, g_final):
    rows = x.shape[1] // GRID_W
    rotary = grid_rotary(rows)
    xc = ctx
    for l in range(DEPTH):
        x, xc = hybrid_layer(x, xc, c, c_ctx, w_ada[l], b_ada[l], g_mix[l], g_ffn[l], w_in[l], w_s[l], b_s[l],
                             g_sgu[l], decay_logit[l], w_pa[l], w_pb[l], w_out[l], w_group[l], b_group[l],
                             w_erouter[l], b_erouter[l], w1[l], w3[l], w2[l], rotary, l < DEPTH - 1)
    return rmsnorm(x, g_final)
```

```cpp
#include <hip/hip_runtime.h>
#include <cstdio>
#include <cstdint>
#include <cmath>

typedef unsigned short bf16_t;
typedef float f32x4 __attribute__((ext_vector_type(4)));
typedef float f32x2 __attribute__((ext_vector_type(2)));
typedef unsigned u32x4 __attribute__((ext_vector_type(4)));
typedef unsigned u32x2 __attribute__((ext_vector_type(2)));
typedef short bf16x8 __attribute__((ext_vector_type(8)));

constexpr int D = 1024, NB = 8, SEQ = 4096, CTXL = 256, DEPTH = 2;
constexpr int TX = NB * SEQ, TC = NB * CTXL, MT = TX + TC;
constexpr int DIN = 7168;
constexpr int C_U = 0, C_VA = 1024, C_Q = 2048, C_K = 2560, C_V = 3072, C_GR = 4096, C_GA = 5120, C_GB = 6144;
constexpr int NGRP = 2, GB = NB / NGRP;
constexpr int GX = GB * SEQ, GC = GB * CTXL, GR = GX + GC;
constexpr int NHEAD = 4, DK = 128, DV = 256, CH = 128;
constexpr int NEXP = 32, EFF = 512;
constexpr int SLOT_CAP = 2 * MT + NEXP * 256;
constexpr float EPS = 1e-6f;

constexpr size_t MiB = 1u << 20;
constexpr size_t WS_CTL = 0;
constexpr size_t CTL_BYTES = 1 * MiB;
constexpr size_t WS_MOD = 1 * MiB;
constexpr size_t WS_TAB = 2 * MiB;
constexpr size_t WS_CTXRES = 8 * MiB;
constexpr size_t WS_WIN = 16 * MiB;
constexpr size_t WS_WPROJ = 44 * MiB;
constexpr size_t WS_WS = 56 * MiB;
constexpr size_t WS_ROT = 57 * MiB;
constexpr size_t WS_WMOE = 60 * MiB;
constexpr size_t WS_H = 156 * MiB;
constexpr size_t WS_KV = 224 * MiB;
constexpr size_t WS_P = 292 * MiB;
constexpr size_t WS_END = 530 * MiB;
constexpr size_t P_BYTES = (size_t)GR * DIN * 2;
static_assert(WS_P + P_BYTES <= WS_END, "ws map");
constexpr size_t WS_MOEH = WS_P;
constexpr size_t WS_MOEY = WS_P + 76 * MiB;
static_assert((size_t)SLOT_CAP * EFF * 2 <= 76 * MiB && WS_MOEY + (size_t)SLOT_CAP * D * 2 <= WS_END, "moe map");

constexpr size_t TAB_TOKE = 0;
constexpr size_t TAB_TOKP = TAB_TOKE + (size_t)MT * 8;
constexpr size_t TAB_TOKW = TAB_TOKP + (size_t)MT * 8;
constexpr size_t TAB_LIST = 1 * MiB;
static_assert(TAB_TOKW + (size_t)MT * 8 <= TAB_LIST && TAB_LIST + (size_t)NEXP * MT * 4 <= 6 * MiB, "tab map");
constexpr int CW_CNT = 64;
constexpr int CW_BASE = 256;
constexpr int CW_BAR = 4096;

__device__ __forceinline__ float bf2f(bf16_t v) { return __uint_as_float(((unsigned)v) << 16); }
__device__ __forceinline__ unsigned f2bf(float f) { unsigned u = __float_as_uint(f); return (u + 0x7fffu + ((u >> 16) & 1u)) >> 16; }
__device__ __forceinline__ unsigned pk2(float lo, float hi) { return f2bf(lo) | (f2bf(hi) << 16); }
__device__ __forceinline__ float sigmoidf_(float x) { return 1.0f / (1.0f + __expf(-x)); }
__device__ __forceinline__ float siluf_(float x) { return x / (1.0f + __expf(-x)); }
__device__ __forceinline__ float geluf_(float x) { const float z = 0.7978845608028654f * (x + 0.044715f * x * x * x); return x / (1.0f + __expf(-2.0f * z)); }
__device__ __forceinline__ float wave_sum(float v) {
#pragma unroll
    for (int o = 1; o < 64; o <<= 1) v += __shfl_xor(v, o);
    return v;
}
struct RowInfo { int b, is_ctx, nat, mj; };
__device__ __forceinline__ RowInfo rinfo(int R) {
    RowInfo r; const int g = R / GR, loc = R - g * GR;
    if (loc < GX) { r.b = g * GB + (loc >> 12); r.is_ctx = 0; r.nat = r.b * SEQ + (loc & 4095); r.mj = r.b; }
    else { const int lc = loc - GX; r.b = g * GB + (lc >> 8); r.is_ctx = 1; r.nat = r.b * CTXL + (lc & 255); r.mj = 8; }
    return r;
}
__device__ __forceinline__ void st4bf(bf16_t* p, f32x4 v) { u32x2 w; w.x = pk2(v.x, v.y); w.y = pk2(v.z, v.w); *(u32x2*)p = w; }
__device__ __forceinline__ f32x4 ld4bf(const bf16_t* p) { const u32x2 w = *(const u32x2*)p; return (f32x4){bf2f((bf16_t)(w.x & 0xffffu)), bf2f((bf16_t)(w.x >> 16)), bf2f((bf16_t)(w.y & 0xffffu)), bf2f((bf16_t)(w.y >> 16))}; }

struct EpiIn {
    bf16_t* P; const float* rot;
    __device__ __forceinline__ void operator()(int row, int col0, f32x4 v) const {
        if (col0 < C_Q) { v = (f32x4){geluf_(v.x), geluf_(v.y), geluf_(v.z), geluf_(v.w)}; }
        else if (col0 < C_V) {
            if (col0 >= C_K) v = v * 0.08838834764831845f;
            if (row < GX) {
                const int n = row & (SEQ - 1), i2 = ((col0 - C_Q) & 127) >> 1;
                const f32x4 cs = *(const f32x4*)(rot + ((size_t)n * 64 + i2) * 2);
                v = (f32x4){v.x * cs.x - v.y * cs.y, v.x * cs.y + v.y * cs.x, v.z * cs.z - v.w * cs.w, v.z * cs.w + v.w * cs.z};
            }
        }
        else if (col0 < C_GR) { }
        else if (col0 < C_GA) { v = (f32x4){siluf_(v.x), siluf_(v.y), siluf_(v.z), siluf_(v.w)}; }
        else { v = (f32x4){sigmoidf_(v.x), sigmoidf_(v.y), sigmoidf_(v.z), sigmoidf_(v.w)}; }
        st4bf(P + (size_t)row * DIN + col0, v);
    }
};
struct EpiMergeA {
    bf16_t* P;
    __device__ __forceinline__ void operator()(int row, int col0, f32x4 v) const {
        bf16_t* p = P + (size_t)row * DIN + C_GA + col0; st4bf(p, ld4bf(p) * v);
    }
};
struct EpiMergeB {
    bf16_t* P;
    __device__ __forceinline__ void operator()(int row, int col0, f32x4 v) const {
        bf16_t* p = P + (size_t)row * DIN + C_GA + col0; st4bf(p, ld4bf(p) + ld4bf(P + (size_t)row * DIN + C_GB + col0) * v);
    }
};
struct EpiOut {
    const float* xsrc; const float* csrc; float* xdst; float* cdst; const float* mod_l; int g;
    __device__ __forceinline__ void operator()(int row, int col0, f32x4 v) const {
        const RowInfo ri = rinfo(g * GR + row);
        const size_t off = (size_t)ri.nat * D + col0;
        const f32x4 gt = *(const f32x4*)(mod_l + ri.mj * 6144 + 2 * 1024 + col0);
        if (ri.is_ctx) *(f32x4*)(cdst + off) = *(const f32x4*)(csrc + off) + gt * v;
        else *(f32x4*)(xdst + off) = *(const f32x4*)(xsrc + off) + gt * v;
    }
};
namespace nv {

__global__ __launch_bounds__(512) void k_mod(const float* c, const float* c_ctx, const float* w_ada, const float* b_ada, float* mod) {
    __shared__ float sc[9][1024];
    __shared__ float red[8][9][64];
    const int t = threadIdx.x, l = blockIdx.x / 96, n0 = (blockIdx.x % 96) * 64;
    for (int i = t; i < 9 * 1024; i += 512) { const int j = i >> 10, k = i & 1023; const float v = j < 8 ? c[j * 1024 + k] : c_ctx[k]; sc[j][k] = v / (1.0f + expf(-v)); }
    __syncthreads();
    const int col = t & 63, ks = t >> 6;
    float acc[9];
#pragma unroll
    for (int j = 0; j < 9; ++j) acc[j] = 0.f;
    const float* w = w_ada + (size_t)l * 1024 * 6144 + n0 + col;
    for (int k = ks * 128; k < ks * 128 + 128; ++k) {
        const float wv = w[(size_t)k * 6144];
#pragma unroll
        for (int j = 0; j < 9; ++j) acc[j] += sc[j][k] * wv;
    }
#pragma unroll
    for (int j = 0; j < 9; ++j) red[ks][j][col] = acc[j];
    __syncthreads();
    for (int i = t; i < 9 * 64; i += 512) {
        const int j = i >> 6, cc = i & 63; float s = 0.f;
#pragma unroll
        for (int q = 0; q < 8; ++q) s += red[q][j][cc];
        mod[(size_t)(l * 9 + j) * 6144 + n0 + cc] = s + b_ada[l * 6144 + n0 + cc];
    }
}

__global__ void k_rot(float* rot) {
    const int i = blockIdx.x * blockDim.x + threadIdx.x; if (i >= SEQ * 64) return;
    const int n = i >> 6, i2 = i & 63;
    const float inv = powf(10000.0f, -(float)(i2 & 31) / 32.0f);
    const float pos = (i2 < 32) ? (float)(n >> 6) : (float)(n & 63);
    const float ang = pos * inv; float s, c; sincosf(ang, &s, &c);
    rot[2 * i] = c; rot[2 * i + 1] = s;
}

__device__ __forceinline__ void norm_mod_row(const float* src, const float* gvec, const float* sc, const float* sh, int lane, f32x4 (&v)[4]) {
    float ss = 0.f;
#pragma unroll
    for (int j = 0; j < 4; ++j) { v[j] = *(const f32x4*)(src + 4 * lane + 256 * j); ss += (v[j].x * v[j].x + v[j].y * v[j].y) + (v[j].z * v[j].z + v[j].w * v[j].w); }
    const float rstd = 1.0f / sqrtf(wave_sum(ss) * (1.0f / 1024.0f) + EPS);
#pragma unroll
    for (int j = 0; j < 4; ++j) {
        const f32x4 g = *(const f32x4*)(gvec + 4 * lane + 256 * j), s1 = *(const f32x4*)(sc + 4 * lane + 256 * j), s0 = *(const f32x4*)(sh + 4 * lane + 256 * j);
        v[j] = (v[j] * rstd * g) * (1.0f + s1) + s0;
    }
}
__device__ __forceinline__ void store_row_bf16(bf16_t* dst, int lane, const f32x4 (&v)[4]) {
#pragma unroll
    for (int j = 0; j < 4; ++j) { u32x2 w; w.x = pk2(v[j].x, v[j].y); w.y = pk2(v[j].z, v[j].w); *(u32x2*)(dst + 4 * lane + 256 * j) = w; }
}

__global__ __launch_bounds__(512) void k_norm1(const float* xs, const float* cs, const float* gvec, const float* mod_l, bf16_t* h) {
    const int lane = threadIdx.x & 63, R = blockIdx.x * 8 + (threadIdx.x >> 6); if (R >= MT) return;
    const RowInfo ri = rinfo(R);
    const float* src = ri.is_ctx ? cs + (size_t)ri.nat * D : xs + (size_t)ri.nat * D;
    f32x4 v[4]; norm_mod_row(src, gvec, mod_l + ri.mj * 6144 + 1024, mod_l + ri.mj * 6144 + 0, lane, v);
    store_row_bf16(h + (size_t)R * D, lane, v);
}

__global__ __launch_bounds__(512) void k_norm2(const float* xs, const float* cs, const float* gvec, const float* mod_l, bf16_t* h,
                                                const float* w_group, const float* b_group, const float* w_er, const float* b_er,
                                                unsigned* cnt, int* tok_e, int* tok_p, float* tok_w, int* list, int with_ctx) {
    const int lane = threadIdx.x & 63, R = blockIdx.x * 8 + (threadIdx.x >> 6); if (R >= MT) return;
    const RowInfo ri = rinfo(R); if (ri.is_ctx && !with_ctx) return;
    const float* src = ri.is_ctx ? cs + (size_t)ri.nat * D : xs + (size_t)ri.nat * D;
    f32x4 v[4]; norm_mod_row(src, gvec, mod_l + ri.mj * 6144 + 4 * 1024, mod_l + ri.mj * 6144 + 3 * 1024, lane, v);
    store_row_bf16(h + (size_t)R * D, lane, v);
    float gl[4], el[32];
#pragma unroll
    for (int o = 0; o < 4; ++o) { float s = 0.f;
#pragma unroll
        for (int j = 0; j < 4; ++j)
#pragma unroll
            for (int e = 0; e < 4; ++e) s += v[j][e] * w_group[(size_t)(4 * lane + e + 256 * j) * 4 + o];
        gl[o] = wave_sum(s) + b_group[o]; }
#pragma unroll
    for (int o = 0; o < 32; ++o) { float s = 0.f;
#pragma unroll
        for (int j = 0; j < 4; ++j)
#pragma unroll
            for (int e = 0; e < 4; ++e) s += v[j][e] * w_er[(size_t)(4 * lane + e + 256 * j) * 32 + o];
        el[o] = wave_sum(s) + b_er[o]; }
    int gs = 0; float gt = gl[0];
#pragma unroll
    for (int o = 1; o < 4; ++o) if (gl[o] > gt) { gt = gl[o]; gs = o; }
    float den = 0.f;
#pragma unroll
    for (int o = 0; o < 4; ++o) den += expf(gl[o] - gt);
    const float pg = 1.0f / den;
    float eg[8];
#pragma unroll
    for (int j = 0; j < 8; ++j) eg[j] = gs == 0 ? el[j] : gs == 1 ? el[8 + j] : gs == 2 ? el[16 + j] : el[24 + j];
    int i0 = 0; float e0 = eg[0];
#pragma unroll
    for (int j = 1; j < 8; ++j) if (eg[j] > e0) { e0 = eg[j]; i0 = j; }
    int i1 = -1; float e1 = -3.0e38f;
#pragma unroll
    for (int j = 0; j < 8; ++j) if (j != i0 && eg[j] > e1) { e1 = eg[j]; i1 = j; }
    const float x1 = expf(e1 - e0), w0 = pg / (1.0f + x1), w1 = pg * x1 / (1.0f + x1);
    if (lane == 0) {
        const int ea = gs * 8 + i0, eb = gs * 8 + i1;
        const int pa = (int)atomicAdd(cnt + ea, 1u), pb = (int)atomicAdd(cnt + eb, 1u);
        list[(size_t)ea * MT + pa] = R; list[(size_t)eb * MT + pb] = R;
        tok_e[2 * R] = ea; tok_e[2 * R + 1] = eb; tok_p[2 * R] = pa; tok_p[2 * R + 1] = pb; tok_w[2 * R] = w0; tok_w[2 * R + 1] = w1;
    }
}
__global__ void k_offsets(const unsigned* cnt, unsigned* base) {
    if (threadIdx.x == 0) { unsigned b = 0; for (int e = 0; e < NEXP; ++e) { base[e] = b; b += ((cnt[e] + 255u) / 256u) * 256u; } base[NEXP] = b; }
}

template <class F> __global__ __launch_bounds__(512) void k_gemm(F f) {
    __shared__ float As[16][132];
    __shared__ float Bs[16][68];
    const int t = threadIdx.x, row0 = blockIdx.y * 128, col0 = blockIdx.x * 64;
    if (!f.tile_active(row0)) return;
    const float* B = f.b_ptr(row0); const int ldb = f.ldb(), K = f.K();
    const int tm = t >> 4, tn = t & 15;
    float acc[4][4];
#pragma unroll
    for (int i = 0; i < 4; ++i)
#pragma unroll
        for (int j = 0; j < 4; ++j) acc[i][j] = 0.f;
    const int ar = t >> 2, ak = (t & 3) * 4;
    const bf16_t* arow = f.a_row(row0 + ar);
    const int bk = t >> 5, bn = (t & 31) * 2;
    for (int k0 = 0; k0 < K; k0 += 16) {
        const u32x2 av = *(const u32x2*)(arow + k0 + ak);
        As[ak + 0][ar] = bf2f((bf16_t)(av.x & 0xffffu)); As[ak + 1][ar] = bf2f((bf16_t)(av.x >> 16));
        As[ak + 2][ar] = bf2f((bf16_t)(av.y & 0xffffu)); As[ak + 3][ar] = bf2f((bf16_t)(av.y >> 16));
        const f32x2 bv = *(const f32x2*)(B + (size_t)(k0 + bk) * ldb + col0 + bn);
        Bs[bk][bn] = bv.x; Bs[bk][bn + 1] = bv.y;
        __syncthreads();
#pragma unroll
        for (int kk = 0; kk < 16; ++kk) {
            float a[4], b[4];
#pragma unroll
            for (int i = 0; i < 4; ++i) { a[i] = As[kk][tm * 4 + i]; b[i] = Bs[kk][tn * 4 + i]; }
#pragma unroll
            for (int i = 0; i < 4; ++i)
#pragma unroll
                for (int j = 0; j < 4; ++j) acc[i][j] += a[i] * b[j];
        }
        __syncthreads();
    }
#pragma unroll
    for (int i = 0; i < 4; ++i) f.epi(row0 + tm * 4 + i, col0 + tn * 4, (f32x4){acc[i][0], acc[i][1], acc[i][2], acc[i][3]});
}

__global__ __launch_bounds__(512) void k_sgu(bf16_t* P, const float* w_s_l, const float* b_s_l, const float* g_sgu_l) {
    extern __shared__ __attribute__((aligned(16))) float sm[];
    float* vn = sm; float* w = sm + 128 * 128; float* mu = w + 128 * 129; float* rs = mu + 128;
    const int t = threadIdx.x, lane = t & 63, wv = t >> 6, g = blockIdx.y, c = blockIdx.x;
    const int row0 = c < GB * 32 ? (c >> 5) * SEQ + (c & 31) * CH : GX + ((c - GB * 32) >> 1) * CTXL + ((c - GB * 32) & 1) * CH;
    for (int r = wv * 16; r < wv * 16 + 16; ++r) {
        const bf16_t* src = P + (size_t)(row0 + r) * DIN + C_VA; float s = 0.f, s2 = 0.f;
#pragma unroll
        for (int j = 0; j < 16; ++j) { const float x = bf2f(src[lane + 64 * j]); s += x; s2 += x * x; }
        s = wave_sum(s); s2 = wave_sum(s2);
        const float m = s * (1.0f / 1024.0f), var = s2 * (1.0f / 1024.0f) - m * m;
        if (lane == 0) { mu[r] = m; rs[r] = 1.0f / sqrtf(fmaxf(var, 0.f) + EPS); }
    }
    __syncthreads();
    for (int i = t; i < 128 * 128; i += 512) { const int q = i >> 7, cc = i & 127;
        vn[i] = (bf2f(P[(size_t)(row0 + q) * DIN + C_VA + g * 128 + cc]) - mu[q]) * rs[q] * g_sgu_l[g * 128 + cc];
        w[q * 129 + cc] = w_s_l[(size_t)g * 128 * 128 + i]; }
    __syncthreads();
    const int p = t >> 2, c0 = (t & 3) * 32;
    float acc[32];
#pragma unroll
    for (int j = 0; j < 32; ++j) acc[j] = 0.f;
    for (int q = 0; q < 128; ++q) { const float wq = w[p * 129 + q];
#pragma unroll
        for (int j = 0; j < 32; ++j) acc[j] += wq * vn[q * 128 + c0 + j]; }
    const float bs = b_s_l[g * 128 + p];
    bf16_t* dst = P + (size_t)(row0 + p) * DIN + C_U + g * 128 + c0;
#pragma unroll
    for (int j = 0; j < 32; ++j) dst[j] = (bf16_t)f2bf(bf2f(dst[j]) * (acc[j] + bs));
}

__global__ __launch_bounds__(512) void k_ret(bf16_t* P, const float* decay_l, int is_ctx_seq) {
    __shared__ float qs[32][129];
    __shared__ float ks[32][129];
    __shared__ __attribute__((aligned(16))) bf16_t vs[32][256];
    __shared__ float ps[32][33];
    const int t = threadIdx.x, hh = blockIdx.y, lb = blockIdx.z, n0 = blockIdx.x * 32;
    const int N = is_ctx_seq ? CTXL : SEQ;
    const int seq_row0 = is_ctx_seq ? GX + lb * CTXL : lb * SEQ, ctx_row0 = GX + lb * CTXL;
    const float df = decay_l[hh], db = decay_l[4 + hh];
    const float lgf = -log1pf(expf(-df)), lgb = -log1pf(expf(-db));
    { const int r = t >> 4, c8 = (t & 15) * 8; const bf16_t* src = P + (size_t)(seq_row0 + n0 + r) * DIN + C_Q + hh * DK + c8;
#pragma unroll
      for (int j = 0; j < 8; ++j) qs[r][c8 + j] = bf2f(src[j]); }
    const int orow = t >> 4, e0 = (t & 15) * 16;
    const int sn = t >> 4, sm0 = (t & 15) * 2;
    float acc[16];
#pragma unroll
    for (int j = 0; j < 16; ++j) acc[j] = 0.f;
    const int n_ctx_tiles = is_ctx_seq ? 0 : CTXL / 32, n_tiles = n_ctx_tiles + N / 32;
    for (int tile = 0; tile < n_tiles; ++tile) {
        const bool from_ctx = tile < n_ctx_tiles;
        const int m0 = from_ctx ? tile * 32 : (tile - n_ctx_tiles) * 32;
        const int krow0 = from_ctx ? ctx_row0 + m0 : seq_row0 + m0;
        __syncthreads();
        { const int r = t >> 4, c8 = (t & 15) * 8; const bf16_t* src = P + (size_t)(krow0 + r) * DIN + C_K + hh * DK + c8;
#pragma unroll
          for (int j = 0; j < 8; ++j) ks[r][c8 + j] = bf2f(src[j]);
          const bf16_t* vsrc = P + (size_t)(krow0 + r) * DIN + C_V + hh * DV + (t & 15) * 16;
          *(u32x4*)&vs[r][(t & 15) * 16] = *(const u32x4*)vsrc; *(u32x4*)&vs[r][(t & 15) * 16 + 8] = *(const u32x4*)(vsrc + 8); }
        __syncthreads();
        float s0 = 0.f, s1 = 0.f;
#pragma unroll 8
        for (int d = 0; d < 128; ++d) { const float qv = qs[sn][d]; s0 += qv * ks[sm0][d]; s1 += qv * ks[sm0 + 1][d]; }
        const int n = n0 + sn;
#pragma unroll
        for (int u = 0; u < 2; ++u) { const int m = m0 + sm0 + u; float wgt;
            if (from_ctx) wgt = expf(lgf * (float)(n + CTXL - m)) + expf(lgb * (float)(N - n + m));
            else wgt = (m <= n) ? expf(lgf * (float)(n - m)) : expf(lgb * (float)(m - n));
            ps[sn][sm0 + u] = (u == 0 ? s0 : s1) * wgt; }
        __syncthreads();
#pragma unroll 4
        for (int mm = 0; mm < 32; ++mm) { const float pv = ps[orow][mm];
#pragma unroll
            for (int j = 0; j < 16; ++j) acc[j] += pv * bf2f(vs[mm][e0 + j]); }
    }
    float s = 0.f;
#pragma unroll
    for (int j = 0; j < 16; ++j) s += acc[j];
    s += __shfl_xor(s, 1); s += __shfl_xor(s, 2); s += __shfl_xor(s, 4); s += __shfl_xor(s, 8);
    const float mean = s * (1.0f / 256.0f); float q2 = 0.f;
#pragma unroll
    for (int j = 0; j < 16; ++j) { const float d = acc[j] - mean; q2 += d * d; }
    q2 += __shfl_xor(q2, 1); q2 += __shfl_xor(q2, 2); q2 += __shfl_xor(q2, 4); q2 += __shfl_xor(q2, 8);
    const float rstd = 1.0f / sqrtf(q2 * (1.0f / 256.0f) + EPS);
    bf16_t* dst = P + (size_t)(seq_row0 + n0 + orow) * DIN + C_GR + hh * DV + e0;
#pragma unroll
    for (int j = 0; j < 16; ++j) dst[j] = (bf16_t)f2bf(bf2f(dst[j]) * ((acc[j] - mean) * rstd));
}

__global__ __launch_bounds__(512) void k_combine(float* xres, float* cres, const bf16_t* Y, const unsigned* base, const int* tok_e, const int* tok_p, const float* tok_w,
                                                  const float* mod_l, int with_ctx, int last, const float* gnext, const float* mod_next, bf16_t* h, const float* g_final) {
    const int lane = threadIdx.x & 63, R = blockIdx.x * 8 + (threadIdx.x >> 6); if (R >= MT) return;
    const RowInfo ri = rinfo(R); if (ri.is_ctx && !with_ctx) return;
    float* xr = ri.is_ctx ? cres + (size_t)ri.nat * D : xres + (size_t)ri.nat * D;
    const unsigned sa = base[tok_e[2 * R]] + (unsigned)tok_p[2 * R], sb = base[tok_e[2 * R + 1]] + (unsigned)tok_p[2 * R + 1];
    const float wa = tok_w[2 * R], wb = tok_w[2 * R + 1];
    const float* gt2 = mod_l + ri.mj * 6144 + 5 * 1024;
    f32x4 v[4]; float ss = 0.f;
#pragma unroll
    for (int j = 0; j < 4; ++j) {
        const int c = 4 * lane + 256 * j;
        const u32x2 ya = *(const u32x2*)(Y + (size_t)sa * D + c), yb = *(const u32x2*)(Y + (size_t)sb * D + c);
        f32x4 y; y.x = wa * bf2f((bf16_t)(ya.x & 0xffffu)) + wb * bf2f((bf16_t)(yb.x & 0xffffu)); y.y = wa * bf2f((bf16_t)(ya.x >> 16)) + wb * bf2f((bf16_t)(yb.x >> 16));
        y.z = wa * bf2f((bf16_t)(ya.y & 0xffffu)) + wb * bf2f((bf16_t)(yb.y & 0xffffu)); y.w = wa * bf2f((bf16_t)(ya.y >> 16)) + wb * bf2f((bf16_t)(yb.y >> 16));
        v[j] = *(const f32x4*)(xr + c) + *(const f32x4*)(gt2 + c) * y;
        ss += (v[j].x * v[j].x + v[j].y * v[j].y) + (v[j].z * v[j].z + v[j].w * v[j].w);
    }
    const float rstd = 1.0f / sqrtf(wave_sum(ss) * (1.0f / 1024.0f) + EPS);
    if (last) {
#pragma unroll
        for (int j = 0; j < 4; ++j) { const int c = 4 * lane + 256 * j; *(f32x4*)(xr + c) = v[j] * rstd * *(const f32x4*)(g_final + c); }
    } else {
        const float* sc = mod_next + ri.mj * 6144 + 1024; const float* sh = mod_next + ri.mj * 6144;
        f32x4 o[4];
#pragma unroll
        for (int j = 0; j < 4; ++j) { const int c = 4 * lane + 256 * j; *(f32x4*)(xr + c) = v[j];
            o[j] = (v[j] * rstd * *(const f32x4*)(gnext + c)) * (1.0f + *(const f32x4*)(sc + c)) + *(const f32x4*)(sh + c); }
        store_row_bf16(h + (size_t)R * D, lane, o);
    }
}
}
namespace nv {
template <class E> struct FDense {
    const bf16_t* A; int lda; const float* B; int ldb_, K_; E e;
    __device__ __forceinline__ int K() const { return K_; }
    __device__ __forceinline__ int ldb() const { return ldb_; }
    __device__ __forceinline__ bool tile_active(int) const { return true; }
    __device__ __forceinline__ const float* b_ptr(int) const { return B; }
    __device__ __forceinline__ const bf16_t* a_row(int r) const { return A + (size_t)r * lda; }
    __device__ __forceinline__ void epi(int r, int c, f32x4 v) const { e(r, c, v); }
};
struct MoeCtx { const unsigned* cnt; const unsigned* base; const int* list; };
__device__ __forceinline__ int moe_expert_of(const unsigned* base, unsigned slot) { int e = 0;
#pragma unroll 1
    for (int i = 1; i < NEXP; ++i) if (base[i] <= slot) e = i; return e; }
struct FMoe1 {
    MoeCtx m; const bf16_t* h2; const float* W; float* G1; bf16_t* Hout; int second;
    __device__ __forceinline__ int K() const { return D; }
    __device__ __forceinline__ int ldb() const { return EFF; }
    __device__ __forceinline__ bool tile_active(int row0) const { return (unsigned)row0 < m.base[NEXP]; }
    __device__ __forceinline__ const float* b_ptr(int row0) const { return W + (size_t)moe_expert_of(m.base, (unsigned)row0) * D * EFF; }
    __device__ __forceinline__ const bf16_t* a_row(int r) const { const int e = moe_expert_of(m.base, (unsigned)r); const unsigned pos = (unsigned)r - m.base[e];
        const int tok = pos < m.cnt[e] ? m.list[(size_t)e * MT + pos] : 0; return h2 + (size_t)tok * D; }
    __device__ __forceinline__ void epi(int r, int c, f32x4 v) const {
        if (!second) *(f32x4*)(G1 + (size_t)r * EFF + c) = v;
        else { const f32x4 a = *(const f32x4*)(G1 + (size_t)r * EFF + c); st4bf(Hout + (size_t)r * EFF + c, (f32x4){siluf_(a.x) * v.x, siluf_(a.y) * v.y, siluf_(a.z) * v.z, siluf_(a.w) * v.w}); }
    }
};
struct FMoe2 {
    MoeCtx m; const bf16_t* Hin; const float* W; bf16_t* Y;
    __device__ __forceinline__ int K() const { return EFF; }
    __device__ __forceinline__ int ldb() const { return D; }
    __device__ __forceinline__ bool tile_active(int row0) const { return (unsigned)row0 < m.base[NEXP]; }
    __device__ __forceinline__ const float* b_ptr(int row0) const { return W + (size_t)moe_expert_of(m.base, (unsigned)row0) * EFF * D; }
    __device__ __forceinline__ const bf16_t* a_row(int r) const { return Hin + (size_t)r * EFF; }
    __device__ __forceinline__ void epi(int r, int c, f32x4 v) const { st4bf(Y + (size_t)r * D + c, v); }
};
}

struct Ptrs {
    const float *x, *c, *ctx, *c_ctx, *w_ada, *b_ada, *g_mix, *g_ffn, *w_in, *w_s, *b_s, *g_sgu, *decay, *w_pa, *w_pb, *w_out, *w_group, *b_group, *w_er, *b_er, *w1, *w3, *w2, *g_final;
    float* out; unsigned char* ws;
    unsigned* ctl; float* mod; float* cres; float* rot; bf16_t* h; bf16_t* P; bf16_t* KV;
    int *tok_e, *tok_p; float* tok_w; int* list;
};
static Ptrs make_ptrs(void* const* d_in, void* d_out, void* d_ws) {
    Ptrs p{}; const float* const* in = (const float* const*)d_in;
    p.x = in[0]; p.c = in[1]; p.ctx = in[2]; p.c_ctx = in[3]; p.w_ada = in[4]; p.b_ada = in[5]; p.g_mix = in[6]; p.g_ffn = in[7]; p.w_in = in[8]; p.w_s = in[9]; p.b_s = in[10]; p.g_sgu = in[11];
    p.decay = in[12]; p.w_pa = in[13]; p.w_pb = in[14]; p.w_out = in[15]; p.w_group = in[16]; p.b_group = in[17]; p.w_er = in[18]; p.b_er = in[19]; p.w1 = in[20]; p.w3 = in[21]; p.w2 = in[22]; p.g_final = in[23];
    p.out = (float*)d_out; p.ws = (unsigned char*)d_ws;
    p.ctl = (unsigned*)(p.ws + WS_CTL); p.mod = (float*)(p.ws + WS_MOD); p.cres = (float*)(p.ws + WS_CTXRES); p.rot = (float*)(p.ws + WS_ROT);
    p.h = (bf16_t*)(p.ws + WS_H); p.P = (bf16_t*)(p.ws + WS_P); p.KV = (bf16_t*)(p.ws + WS_KV);
    p.tok_e = (int*)(p.ws + WS_TAB + TAB_TOKE); p.tok_p = (int*)(p.ws + WS_TAB + TAB_TOKP); p.tok_w = (float*)(p.ws + WS_TAB + TAB_TOKW); p.list = (int*)(p.ws + WS_TAB + TAB_LIST);
    return p;
}

static void nv_prologue(const Ptrs& p, hipStream_t s) {
    nv::k_mod<<<192, 512, 0, s>>>(p.c, p.c_ctx, p.w_ada, p.b_ada, p.mod);
    nv::k_rot<<<SEQ * 64 / 256, 256, 0, s>>>(p.rot);
    nv::k_norm1<<<MT / 8, 512, 0, s>>>(p.x, p.ctx, p.g_mix, p.mod, p.h);
}
static void nv_gemm_in(const Ptrs& p, int l, int g, hipStream_t s) {
    nv::FDense<EpiIn> f{}; f.A = p.h + (size_t)g * GR * D; f.lda = D; f.B = p.w_in + (size_t)l * D * DIN; f.ldb_ = DIN; f.K_ = D; f.e.P = p.P; f.e.rot = p.rot;
    nv::k_gemm<<<dim3(DIN / 64, GR / 128), 512, 0, s>>>(f);
}
static void nv_sgu(const Ptrs& p, int l, hipStream_t s) {
    const int chunks = GB * 32 + (l == 0 ? GB * 2 : 0);
    const size_t lds = (size_t)(128 * 128 + 128 * 129 + 256) * 4;
    static bool once = false; if (!once) { (void)hipFuncSetAttribute((const void*)nv::k_sgu, hipFuncAttributeMaxDynamicSharedMemorySize, (int)lds); once = true; }
    nv::k_sgu<<<dim3(chunks, 8), 512, lds, s>>>(p.P, p.w_s + (size_t)l * 8 * 128 * 128, p.b_s + l * 8 * 128, p.g_sgu + l * 1024);
}
static void nv_ret(const Ptrs& p, int l, hipStream_t s) {
    nv::k_ret<<<dim3(SEQ / 32, NHEAD, GB), 512, 0, s>>>(p.P, p.decay + l * 8, 0);
    if (l == 0) nv::k_ret<<<dim3(CTXL / 32, NHEAD, GB), 512, 0, s>>>(p.P, p.decay + l * 8, 1);
}
static void nv_merge(const Ptrs& p, int l, hipStream_t s) {
    const int M = l == 0 ? GR : GX;
    nv::FDense<EpiMergeA> fa{}; fa.A = p.P + C_U; fa.lda = DIN; fa.B = p.w_pa + (size_t)l * D * D; fa.ldb_ = D; fa.K_ = D; fa.e.P = p.P;
    nv::k_gemm<<<dim3(D / 64, M / 128), 512, 0, s>>>(fa);
    nv::FDense<EpiMergeB> fb{}; fb.A = p.P + C_GR; fb.lda = DIN; fb.B = p.w_pb + (size_t)l * D * D; fb.ldb_ = D; fb.K_ = D; fb.e.P = p.P;
    nv::k_gemm<<<dim3(D / 64, M / 128), 512, 0, s>>>(fb);
}
static void nv_out(const Ptrs& p, int l, int g, hipStream_t s) {
    const int M = l == 0 ? GR : GX;
    nv::FDense<EpiOut> f{}; f.A = p.P + C_GA; f.lda = DIN; f.B = p.w_out + (size_t)l * D * D; f.ldb_ = D; f.K_ = D;
    f.e.xsrc = l == 0 ? p.x : p.out; f.e.csrc = l == 0 ? p.ctx : p.cres; f.e.xdst = p.out; f.e.cdst = p.cres; f.e.mod_l = p.mod + (size_t)l * 9 * 6144; f.e.g = g;
    nv::k_gemm<<<dim3(D / 64, M / 128), 512, 0, s>>>(f);
}
static void nv_norm2(const Ptrs& p, int l, hipStream_t s) {
    nv::k_norm2<<<MT / 8, 512, 0, s>>>(p.out, p.cres, p.g_ffn + l * D, p.mod + (size_t)l * 9 * 6144, p.h, p.w_group + l * D * 4, p.b_group + l * 4, p.w_er + l * D * 32, p.b_er + l * 32,
                                       p.ctl + CW_CNT + l * 32, p.tok_e, p.tok_p, p.tok_w, p.list, l == 0 ? 1 : 0);
    nv::k_offsets<<<1, 64, 0, s>>>(p.ctl + CW_CNT + l * 32, p.ctl + CW_BASE + l * 64);
}
static void nv_moe(const Ptrs& p, int l, hipStream_t s) {
    nv::MoeCtx m{p.ctl + CW_CNT + l * 32, p.ctl + CW_BASE + l * 64, p.list};
    bf16_t* H = (bf16_t*)(p.ws + WS_MOEH); float* G1 = (float*)(p.ws + WS_MOEY); bf16_t* Y = (bf16_t*)(p.ws + WS_MOEY);
    nv::FMoe1 f1{}; f1.m = m; f1.h2 = p.h; f1.W = p.w1 + (size_t)l * NEXP * D * EFF; f1.G1 = G1; f1.Hout = H; f1.second = 0;
    nv::k_gemm<<<dim3(EFF / 64, SLOT_CAP / 128), 512, 0, s>>>(f1);
    f1.W = p.w3 + (size_t)l * NEXP * D * EFF; f1.second = 1;
    nv::k_gemm<<<dim3(EFF / 64, SLOT_CAP / 128), 512, 0, s>>>(f1);
    nv::FMoe2 f2{}; f2.m = m; f2.Hin = H; f2.W = p.w2 + (size_t)l * NEXP * EFF * D; f2.Y = Y;
    nv::k_gemm<<<dim3(D / 64, SLOT_CAP / 128), 512, 0, s>>>(f2);
}
static void nv_combine(const Ptrs& p, int l, hipStream_t s) {
    const int last = (l == DEPTH - 1);
    nv::k_combine<<<MT / 8, 512, 0, s>>>(p.out, p.cres, (const bf16_t*)(p.ws + WS_MOEY), p.ctl + CW_BASE + l * 64, p.tok_e, p.tok_p, p.tok_w, p.mod + (size_t)l * 9 * 6144, l == 0 ? 1 : 0, last,
                                         last ? p.g_mix : p.g_mix + (l + 1) * D, last ? p.mod : p.mod + (size_t)(l + 1) * 9 * 6144, p.h, p.g_final);
}
extern "C" void kernel_launch(void* const* d_in, const int* in_sizes, int n_in, void* d_out, int out_size, void* d_ws, size_t ws_size, hipStream_t stream) {
    if (n_in != 24 || out_size != TX * D || ws_size < WS_END) { fprintf(stderr, "kernel_launch: unexpected sizes n_in %d out %d ws %zu\n", n_in, out_size, ws_size); return; }
    const Ptrs p = make_ptrs(d_in, d_out, d_ws);
    (void)hipMemsetAsync(p.ws + WS_CTL, 0, CTL_BYTES, stream);
    nv_prologue(p, stream);
    for (int l = 0; l < DEPTH; ++l) {
        for (int g = 0; g < NGRP; ++g) { nv_gemm_in(p, l, g, stream); nv_sgu(p, l, stream); nv_ret(p, l, stream); nv_merge(p, l, stream); nv_out(p, l, g, stream); }
        nv_norm2(p, l, stream); nv_moe(p, l, stream); nv_combine(p, l, stream);
    }
}
```

```cpp
#include <hip/hip_runtime.h>
#include <cstdio>
#include <cstdint>
#include <cmath>

typedef unsigned short bf16_t;
typedef float f32x4 __attribute__((ext_vector_type(4)));
typedef float f32x2 __attribute__((ext_vector_type(2)));
typedef unsigned u32x4 __attribute__((ext_vector_type(4)));
typedef unsigned u32x2 __attribute__((ext_vector_type(2)));
typedef short bf16x8 __attribute__((ext_vector_type(8)));

constexpr int D = 1024, NB = 8, SEQ = 4096, CTXL = 256, DEPTH = 2;
constexpr int TX = NB * SEQ, TC = NB * CTXL, MT = TX + TC;
constexpr int DIN = 7168;
constexpr int C_U = 0, C_VA = 1024, C_Q = 2048, C_K = 2560, C_V = 3072, C_GR = 4096, C_GA = 5120, C_GB = 6144;
constexpr int NGRP = 2, GB = NB / NGRP;
constexpr int GX = GB * SEQ, GC = GB * CTXL, GR = GX + GC;
constexpr int NHEAD = 4, DK = 128, DV = 256, CH = 128;
constexpr int NEXP = 32, EFF = 512;
constexpr int SLOT_CAP = 2 * MT + NEXP * 256;
constexpr float EPS = 1e-6f;

constexpr size_t MiB = 1u << 20;
constexpr size_t WS_CTL = 0;
constexpr size_t CTL_BYTES = 1 * MiB;
constexpr size_t WS_MOD = 1 * MiB;
constexpr size_t WS_TAB = 2 * MiB;
constexpr size_t WS_CTXRES = 8 * MiB;
constexpr size_t WS_WIN = 16 * MiB;
constexpr size_t WS_WPROJ = 44 * MiB;
constexpr size_t WS_WS = 56 * MiB;
constexpr size_t WS_ROT = 57 * MiB;
constexpr size_t WS_WMOE = 60 * MiB;
constexpr size_t WS_H = 156 * MiB;
constexpr size_t WS_KV = 224 * MiB;
constexpr size_t WS_P = 292 * MiB;
constexpr size_t WS_END = 530 * MiB;
constexpr size_t P_BYTES = (size_t)GR * DIN * 2;
static_assert(WS_P + P_BYTES <= WS_END, "ws map");
constexpr size_t WS_MOEH = WS_P;
constexpr size_t WS_MOEY = WS_P + 76 * MiB;
static_assert((size_t)SLOT_CAP * EFF * 2 <= 76 * MiB && WS_MOEY + (size_t)SLOT_CAP * D * 2 <= WS_END, "moe map");

constexpr size_t TAB_TOKE = 0;
constexpr size_t TAB_TOKP = TAB_TOKE + (size_t)MT * 8;
constexpr size_t TAB_TOKW = TAB_TOKP + (size_t)MT * 8;
constexpr size_t TAB_LIST = 1 * MiB;
static_assert(TAB_TOKW + (size_t)MT * 8 <= TAB_LIST && TAB_LIST + (size_t)NEXP * MT * 4 <= 6 * MiB, "tab map");
constexpr int CW_CNT = 64;
constexpr int CW_BASE = 256;
constexpr int CW_BAR = 4096;

__device__ __forceinline__ float bf2f(bf16_t v) { return __uint_as_float(((unsigned)v) << 16); }
__device__ __forceinline__ unsigned f2bf(float f) { unsigned u = __float_as_uint(f); return (u + 0x7fffu + ((u >> 16) & 1u)) >> 16; }
__device__ __forceinline__ unsigned pk2(float lo, float hi) { return f2bf(lo) | (f2bf(hi) << 16); }
__device__ __forceinline__ float sigmoidf_(float x) { return 1.0f / (1.0f + __expf(-x)); }
__device__ __forceinline__ float siluf_(float x) { return x / (1.0f + __expf(-x)); }
__device__ __forceinline__ float geluf_(float x) { const float z = 0.7978845608028654f * (x + 0.044715f * x * x * x); return x / (1.0f + __expf(-2.0f * z)); }
__device__ __forceinline__ float wave_sum(float v) {
#pragma unroll
    for (int o = 1; o < 64; o <<= 1) v += __shfl_xor(v, o);
    return v;
}
struct RowInfo { int b, is_ctx, nat, mj; };
__device__ __forceinline__ RowInfo rinfo(int R) {
    RowInfo r; const int g = R / GR, loc = R - g * GR;
    if (loc < GX) { r.b = g * GB + (loc >> 12); r.is_ctx = 0; r.nat = r.b * SEQ + (loc & 4095); r.mj = r.b; }
    else { const int lc = loc - GX; r.b = g * GB + (lc >> 8); r.is_ctx = 1; r.nat = r.b * CTXL + (lc & 255); r.mj = 8; }
    return r;
}
__device__ __forceinline__ void st4bf(bf16_t* p, f32x4 v) { u32x2 w; w.x = pk2(v.x, v.y); w.y = pk2(v.z, v.w); *(u32x2*)p = w; }
__device__ __forceinline__ f32x4 ld4bf(const bf16_t* p) { const u32x2 w = *(const u32x2*)p; return (f32x4){bf2f((bf16_t)(w.x & 0xffffu)), bf2f((bf16_t)(w.x >> 16)), bf2f((bf16_t)(w.y & 0xffffu)), bf2f((bf16_t)(w.y >> 16))}; }

struct EpiIn {
    bf16_t* P; const float* rot;
    __device__ __forceinline__ void operator()(int row, int col0, f32x4 v) const {
        if (col0 < C_Q) { v = (f32x4){geluf_(v.x), geluf_(v.y), geluf_(v.z), geluf_(v.w)}; }
        else if (col0 < C_V) {
            if (col0 >= C_K) v = v * 0.08838834764831845f;
            if (row < GX) {
                const int n = row & (SEQ - 1), i2 = ((col0 - C_Q) & 127) >> 1;
                const f32x4 cs = *(const f32x4*)(rot + ((size_t)n * 64 + i2) * 2);
                v = (f32x4){v.x * cs.x - v.y * cs.y, v.x * cs.y + v.y * cs.x, v.z * cs.z - v.w * cs.w, v.z * cs.w + v.w * cs.z};
            }
        }
        else if (col0 < C_GR) { }
        else if (col0 < C_GA) { v = (f32x4){siluf_(v.x), siluf_(v.y), siluf_(v.z), siluf_(v.w)}; }
        else { v = (f32x4){sigmoidf_(v.x), sigmoidf_(v.y), sigmoidf_(v.z), sigmoidf_(v.w)}; }
        st4bf(P + (size_t)row * DIN + col0, v);
    }
};
struct EpiMergeA {
    bf16_t* P;
    __device__ __forceinline__ void operator()(int row, int col0, f32x4 v) const {
        bf16_t* p = P + (size_t)row * DIN + C_GA + col0; st4bf(p, ld4bf(p) * v);
    }
};
struct EpiMergeB {
    bf16_t* P;
    __device__ __forceinline__ void operator()(int row, int col0, f32x4 v) const {
        bf16_t* p = P + (size_t)row * DIN + C_GA + col0; st4bf(p, ld4bf(p) + ld4bf(P + (size_t)row * DIN + C_GB + col0) * v);
    }
};
struct EpiOut {
    const float* xsrc; const float* csrc; float* xdst; float* cdst; const float* mod_l; int g;
    __device__ __forceinline__ void operator()(int row, int col0, f32x4 v) const {
        const RowInfo ri = rinfo(g * GR + row);
        const size_t off = (size_t)ri.nat * D + col0;
        const f32x4 gt = *(const f32x4*)(mod_l + ri.mj * 6144 + 2 * 1024 + col0);
        const float* xs_ = xsrc; const float* cs_ = csrc; float* xd_ = xdst; float* cd_ = cdst;
        const float* src = ri.is_ctx ? cs_ : xs_; float* dst = ri.is_ctx ? cd_ : xd_;
        *(f32x4*)(dst + off) = *(const f32x4*)(src + off) + gt * v;
    }
};
namespace nv {

__device__ __forceinline__ void b_mod(int tid, char* lds, int vb, const float* c, const float* c_ctx, const float* w_ada, const float* b_ada, float* mod) {
    float (*sc)[1024] = (float (*)[1024])lds;
    float (*red)[9][64] = (float (*)[9][64])(lds + 9 * 1024 * 4);
    const int t = tid, l = vb / 96, n0 = (vb % 96) * 64;
    __syncthreads();
    for (int i = t; i < 9 * 1024; i += 512) { const int j = i >> 10, k = i & 1023; const float v = j < 8 ? c[j * 1024 + k] : c_ctx[k]; sc[j][k] = v / (1.0f + expf(-v)); }
    __syncthreads();
    const int col = t & 63, ks = t >> 6;
    float acc[9];
#pragma unroll
    for (int j = 0; j < 9; ++j) acc[j] = 0.f;
    const float* w = w_ada + (size_t)l * 1024 * 6144 + n0 + col;
    for (int k = ks * 128; k < ks * 128 + 128; ++k) {
        const float wv = w[(size_t)k * 6144];
#pragma unroll
        for (int j = 0; j < 9; ++j) acc[j] += sc[j][k] * wv;
    }
#pragma unroll
    for (int j = 0; j < 9; ++j) red[ks][j][col] = acc[j];
    __syncthreads();
    for (int i = t; i < 9 * 64; i += 512) {
        const int j = i >> 6, cc = i & 63; float s = 0.f;
#pragma unroll
        for (int q = 0; q < 8; ++q) s += red[q][j][cc];
        mod[(size_t)(l * 9 + j) * 6144 + n0 + cc] = s + b_ada[l * 6144 + n0 + cc];
    }
}

__device__ __forceinline__ void b_rot(int tid, int vb, float* rot) {
    const int i = vb * 512 + tid; if (i >= SEQ * 64) return;
    const int n = i >> 6, i2 = i & 63;
    const float inv = powf(10000.0f, -(float)(i2 & 31) / 32.0f);
    const float pos = (i2 < 32) ? (float)(n >> 6) : (float)(n & 63);
    const float ang = pos * inv; float s, c; sincosf(ang, &s, &c);
    rot[2 * i] = c; rot[2 * i + 1] = s;
}

__device__ __forceinline__ void norm_mod_row(const float* src, const float* gvec, const float* sc, const float* sh, int lane, f32x4 (&v)[4]) {
    float ss = 0.f;
#pragma unroll
    for (int j = 0; j < 4; ++j) { v[j] = *(const f32x4*)(src + 4 * lane + 256 * j); ss += (v[j].x * v[j].x + v[j].y * v[j].y) + (v[j].z * v[j].z + v[j].w * v[j].w); }
    const float rstd = 1.0f / sqrtf(wave_sum(ss) * (1.0f / 1024.0f) + EPS);
#pragma unroll
    for (int j = 0; j < 4; ++j) {
        const f32x4 g = *(const f32x4*)(gvec + 4 * lane + 256 * j), s1 = *(const f32x4*)(sc + 4 * lane + 256 * j), s0 = *(const f32x4*)(sh + 4 * lane + 256 * j);
        v[j] = (v[j] * rstd * g) * (1.0f + s1) + s0;
    }
}
__device__ __forceinline__ void store_row_bf16(bf16_t* dst, int lane, const f32x4 (&v)[4]) {
#pragma unroll
    for (int j = 0; j < 4; ++j) { u32x2 w; w.x = pk2(v[j].x, v[j].y); w.y = pk2(v[j].z, v[j].w); *(u32x2*)(dst + 4 * lane + 256 * j) = w; }
}

__device__ __forceinline__ void b_norm1(int tid, int vb, const float* xs, const float* cs, const float* gvec, const float* mod_l, bf16_t* h) {
    const int lane = tid & 63, R = vb * 8 + (tid >> 6); if (R >= MT) return;
    const RowInfo ri = rinfo(R);
    const float* src = ri.is_ctx ? cs + (size_t)ri.nat * D : xs + (size_t)ri.nat * D;
    f32x4 v[4]; norm_mod_row(src, gvec, mod_l + ri.mj * 6144 + 1024, mod_l + ri.mj * 6144 + 0, lane, v);
    store_row_bf16(h + (size_t)R * D, lane, v);
}

__device__ __forceinline__ void b_offsets(int tid, const unsigned* cnt, unsigned* base) {
    __syncthreads();
    if (tid == 0) { unsigned b = 0; for (int e = 0; e < NEXP; ++e) { base[e] = b; b += ((__hip_atomic_load(cnt + e, __ATOMIC_RELAXED, __HIP_MEMORY_SCOPE_AGENT) + 255u) / 256u) * 256u; } base[NEXP] = b; }
    __syncthreads();
}

template <class F> __device__ __forceinline__ void b_gemm(int tid, char* lds, int bx, int by, const F f) {
    float (*As)[132] = (float (*)[132])lds;
    float (*Bs)[68] = (float (*)[68])(lds + 16 * 132 * 4);
    const int t = tid, row0 = by * 128, col0 = bx * 64;
    if (!f.tile_active(row0)) return;
    const float* B = f.b_ptr(row0); const int ldb = f.ldb(), K = f.K();
    const int tm = t >> 4, tn = t & 15;
    float acc[4][4];
#pragma unroll
    for (int i = 0; i < 4; ++i)
#pragma unroll
        for (int j = 0; j < 4; ++j) acc[i][j] = 0.f;
    const int ar = t >> 2, ak = (t & 3) * 4;
    const bf16_t* arow = f.a_row(row0 + ar);
    const int bk = t >> 5, bn = (t & 31) * 2;
    for (int k0 = 0; k0 < K; k0 += 16) {
        const u32x2 av = *(const u32x2*)(arow + k0 + ak);
        As[ak + 0][ar] = bf2f((bf16_t)(av.x & 0xffffu)); As[ak + 1][ar] = bf2f((bf16_t)(av.x >> 16));
        As[ak + 2][ar] = bf2f((bf16_t)(av.y & 0xffffu)); As[ak + 3][ar] = bf2f((bf16_t)(av.y >> 16));
        const f32x2 bv = *(const f32x2*)(B + (size_t)(k0 + bk) * ldb + col0 + bn);
        Bs[bk][bn] = bv.x; Bs[bk][bn + 1] = bv.y;
        __syncthreads();
#pragma unroll
        for (int kk = 0; kk < 16; ++kk) {
            float a[4], b[4];
#pragma unroll
            for (int i = 0; i < 4; ++i) { a[i] = As[kk][tm * 4 + i]; b[i] = Bs[kk][tn * 4 + i]; }
#pragma unroll
            for (int i = 0; i < 4; ++i)
#pragma unroll
                for (int j = 0; j < 4; ++j) acc[i][j] += a[i] * b[j];
        }
        __syncthreads();
    }
#pragma unroll
    for (int i = 0; i < 4; ++i) f.epi(row0 + tm * 4 + i, col0 + tn * 4, (f32x4){acc[i][0], acc[i][1], acc[i][2], acc[i][3]});
}

__device__ __forceinline__ void b_sgu(int tid, char* lds, int c, int g, bf16_t* P, const float* w_s_l, const float* b_s_l, const float* g_sgu_l) {
    float* sm = (float*)lds;
    float* vn = sm; float* w = sm + 128 * 128; float* mu = w + 128 * 129; float* rs = mu + 128;
    const int t = tid, lane = t & 63, wv = t >> 6;
    __syncthreads();
    const int row0 = c < GB * 32 ? (c >> 5) * SEQ + (c & 31) * CH : GX + ((c - GB * 32) >> 1) * CTXL + ((c - GB * 32) & 1) * CH;
    for (int r = wv * 16; r < wv * 16 + 16; ++r) {
        const bf16_t* src = P + (size_t)(row0 + r) * DIN + C_VA; float s = 0.f, s2 = 0.f;
#pragma unroll
        for (int j = 0; j < 16; ++j) { const float x = bf2f(src[lane + 64 * j]); s += x; s2 += x * x; }
        s = wave_sum(s); s2 = wave_sum(s2);
        const float m = s * (1.0f / 1024.0f), var = s2 * (1.0f / 1024.0f) - m * m;
        if (lane == 0) { mu[r] = m; rs[r] = 1.0f / sqrtf(fmaxf(var, 0.f) + EPS); }
    }
    __syncthreads();
    for (int i = t; i < 128 * 128; i += 512) { const int q = i >> 7, cc = i & 127;
        vn[i] = (bf2f(P[(size_t)(row0 + q) * DIN + C_VA + g * 128 + cc]) - mu[q]) * rs[q] * g_sgu_l[g * 128 + cc];
        w[q * 129 + cc] = w_s_l[(size_t)g * 128 * 128 + i]; }
    __syncthreads();
    const int p = t >> 2, c0 = (t & 3) * 32;
    float acc[32];
#pragma unroll
    for (int j = 0; j < 32; ++j) acc[j] = 0.f;
    for (int q = 0; q < 128; ++q) { const float wq = w[p * 129 + q];
#pragma unroll
        for (int j = 0; j < 32; ++j) acc[j] += wq * vn[q * 128 + c0 + j]; }
    const float bs = b_s_l[g * 128 + p];
    bf16_t* dst = P + (size_t)(row0 + p) * DIN + C_U + g * 128 + c0;
#pragma unroll
    for (int j = 0; j < 32; ++j) dst[j] = (bf16_t)f2bf(bf2f(dst[j]) * (acc[j] + bs));
}

__device__ __forceinline__ void b_ret(int tid, char* lds, int bx, int hh, int lb, bf16_t* P, const float* decay_l, int is_ctx_seq) {
    float (*qs)[129] = (float (*)[129])lds;
    float (*ks)[129] = (float (*)[129])(lds + 32 * 129 * 4);
    bf16_t (*vs)[256] = (bf16_t (*)[256])(lds + 2 * 32 * 129 * 4);
    float (*ps)[33] = (float (*)[33])(lds + 2 * 32 * 129 * 4 + 32 * 256 * 2);
    const int t = tid, n0 = bx * 32;
    __syncthreads();
    const int N = is_ctx_seq ? CTXL : SEQ;
    const int seq_row0 = is_ctx_seq ? GX + lb * CTXL : lb * SEQ, ctx_row0 = GX + lb * CTXL;
    const float df = decay_l[hh], db = decay_l[4 + hh];
    const float lgf = -log1pf(expf(-df)), lgb = -log1pf(expf(-db));
    { const int r = t >> 4, c8 = (t & 15) * 8; const bf16_t* src = P + (size_t)(seq_row0 + n0 + r) * DIN + C_Q + hh * DK + c8;
#pragma unroll
      for (int j = 0; j < 8; ++j) qs[r][c8 + j] = bf2f(src[j]); }
    const int orow = t >> 4, e0 = (t & 15) * 16;
    const int sn = t >> 4, sm0 = (t & 15) * 2;
    float acc[16];
#pragma unroll
    for (int j = 0; j < 16; ++j) acc[j] = 0.f;
    const int n_ctx_tiles = is_ctx_seq ? 0 : CTXL / 32, n_tiles = n_ctx_tiles + N / 32;
    for (int tile = 0; tile < n_tiles; ++tile) {
        const bool from_ctx = tile < n_ctx_tiles;
        const int m0 = from_ctx ? tile * 32 : (tile - n_ctx_tiles) * 32;
        const int krow0 = from_ctx ? ctx_row0 + m0 : seq_row0 + m0;
        __syncthreads();
        { const int r = t >> 4, c8 = (t & 15) * 8; const bf16_t* src = P + (size_t)(krow0 + r) * DIN + C_K + hh * DK + c8;
#pragma unroll
          for (int j = 0; j < 8; ++j) ks[r][c8 + j] = bf2f(src[j]);
          const bf16_t* vsrc = P + (size_t)(krow0 + r) * DIN + C_V + hh * DV + (t & 15) * 16;
          *(u32x4*)&vs[r][(t & 15) * 16] = *(const u32x4*)vsrc; *(u32x4*)&vs[r][(t & 15) * 16 + 8] = *(const u32x4*)(vsrc + 8); }
        __syncthreads();
        float s0 = 0.f, s1 = 0.f;
#pragma unroll 8
        for (int d = 0; d < 128; ++d) { const float qv = qs[sn][d]; s0 += qv * ks[sm0][d]; s1 += qv * ks[sm0 + 1][d]; }
        const int n = n0 + sn;
#pragma unroll
        for (int u = 0; u < 2; ++u) { const int m = m0 + sm0 + u; float wgt;
            if (from_ctx) wgt = expf(lgf * (float)(n + CTXL - m)) + expf(lgb * (float)(N - n + m));
            else wgt = (m <= n) ? expf(lgf * (float)(n - m)) : expf(lgb * (float)(m - n));
            ps[sn][sm0 + u] = (u == 0 ? s0 : s1) * wgt; }
        __syncthreads();
#pragma unroll 4
        for (int mm = 0; mm < 32; ++mm) { const float pv = ps[orow][mm];
#pragma unroll
            for (int j = 0; j < 16; ++j) acc[j] += pv * bf2f(vs[mm][e0 + j]); }
    }
    float s = 0.f;
#pragma unroll
    for (int j = 0; j < 16; ++j) s += acc[j];
    s += __shfl_xor(s, 1); s += __shfl_xor(s, 2); s += __shfl_xor(s, 4); s += __shfl_xor(s, 8);
    const float mean = s * (1.0f / 256.0f); float q2 = 0.f;
#pragma unroll
    for (int j = 0; j < 16; ++j) { const float d = acc[j] - mean; q2 += d * d; }
    q2 += __shfl_xor(q2, 1); q2 += __shfl_xor(q2, 2); q2 += __shfl_xor(q2, 4); q2 += __shfl_xor(q2, 8);
    const float rstd = 1.0f / sqrtf(q2 * (1.0f / 256.0f) + EPS);
    bf16_t* dst = P + (size_t)(seq_row0 + n0 + orow) * DIN + C_GR + hh * DV + e0;
#pragma unroll
    for (int j = 0; j < 16; ++j) dst[j] = (bf16_t)f2bf(bf2f(dst[j]) * ((acc[j] - mean) * rstd));
}

__device__ __forceinline__ void b_combine(int tid, int vb, float* xres, float* cres, const bf16_t* Y, const unsigned* base, const int* tok_e, const int* tok_p, const float* tok_w,
                                                  const float* mod_l, int with_ctx, int last, const float* gnext, const float* mod_next, bf16_t* h, const float* g_final) {
    const int lane = tid & 63, R = vb * 8 + (tid >> 6); if (R >= MT) return;
    const RowInfo ri = rinfo(R); if (ri.is_ctx && !with_ctx) return;
    float* xr = ri.is_ctx ? cres + (size_t)ri.nat * D : xres + (size_t)ri.nat * D;
    const unsigned sa = base[tok_e[2 * R]] + (unsigned)tok_p[2 * R], sb = base[tok_e[2 * R + 1]] + (unsigned)tok_p[2 * R + 1];
    const float wa = tok_w[2 * R], wb = tok_w[2 * R + 1];
    const float* gt2 = mod_l + ri.mj * 6144 + 5 * 1024;
    f32x4 v[4]; float ss = 0.f;
#pragma unroll
    for (int j = 0; j < 4; ++j) {
        const int c = 4 * lane + 256 * j;
        const u32x2 ya = *(const u32x2*)(Y + (size_t)sa * D + c), yb = *(const u32x2*)(Y + (size_t)sb * D + c);
        f32x4 y; y.x = wa * bf2f((bf16_t)(ya.x & 0xffffu)) + wb * bf2f((bf16_t)(yb.x & 0xffffu)); y.y = wa * bf2f((bf16_t)(ya.x >> 16)) + wb * bf2f((bf16_t)(yb.x >> 16));
        y.z = wa * bf2f((bf16_t)(ya.y & 0xffffu)) + wb * bf2f((bf16_t)(yb.y & 0xffffu)); y.w = wa * bf2f((bf16_t)(ya.y >> 16)) + wb * bf2f((bf16_t)(yb.y >> 16));
        v[j] = *(const f32x4*)(xr + c) + *(const f32x4*)(gt2 + c) * y;
        ss += (v[j].x * v[j].x + v[j].y * v[j].y) + (v[j].z * v[j].z + v[j].w * v[j].w);
    }
    const float rstd = 1.0f / sqrtf(wave_sum(ss) * (1.0f / 1024.0f) + EPS);
    if (last) {
#pragma unroll
        for (int j = 0; j < 4; ++j) { const int c = 4 * lane + 256 * j; *(f32x4*)(xr + c) = v[j] * rstd * *(const f32x4*)(g_final + c); }
    } else {
        const float* sc = mod_next + ri.mj * 6144 + 1024; const float* sh = mod_next + ri.mj * 6144;
        f32x4 o[4];
#pragma unroll
        for (int j = 0; j < 4; ++j) { const int c = 4 * lane + 256 * j; *(f32x4*)(xr + c) = v[j];
            o[j] = (v[j] * rstd * *(const f32x4*)(gnext + c)) * (1.0f + *(const f32x4*)(sc + c)) + *(const f32x4*)(sh + c); }
        store_row_bf16(h + (size_t)R * D, lane, o);
    }
}
}
namespace nv {
template <class E> struct FDense {
    const bf16_t* A; int lda; const float* B; int ldb_, K_; E e;
    __device__ __forceinline__ int K() const { return K_; }
    __device__ __forceinline__ int ldb() const { return ldb_; }
    __device__ __forceinline__ bool tile_active(int) const { return true; }
    __device__ __forceinline__ const float* b_ptr(int) const { return B; }
    __device__ __forceinline__ const bf16_t* a_row(int r) const { return A + (size_t)r * lda; }
    __device__ __forceinline__ void epi(int r, int c, f32x4 v) const { e(r, c, v); }
};
struct MoeCtx { const unsigned* cnt; const unsigned* base; const int* list; };
__device__ __forceinline__ int moe_expert_of(const unsigned* base, unsigned slot) { int e = 0;
#pragma unroll 1
    for (int i = 1; i < NEXP; ++i) if (base[i] <= slot) e = i; return e; }
struct FMoe1 {
    MoeCtx m; const bf16_t* h2; const float* W; float* G1; bf16_t* Hout; int second;
    __device__ __forceinline__ int K() const { return D; }
    __device__ __forceinline__ int ldb() const { return EFF; }
    __device__ __forceinline__ bool tile_active(int row0) const { return (unsigned)row0 < m.base[NEXP]; }
    __device__ __forceinline__ const float* b_ptr(int row0) const { return W + (size_t)moe_expert_of(m.base, (unsigned)row0) * D * EFF; }
    __device__ __forceinline__ const bf16_t* a_row(int r) const { const int e = moe_expert_of(m.base, (unsigned)r); const unsigned pos = (unsigned)r - m.base[e];
        const int tok = pos < m.cnt[e] ? m.list[(size_t)e * MT + pos] : 0; return h2 + (size_t)tok * D; }
    __device__ __forceinline__ void epi(int r, int c, f32x4 v) const {
        if (!second) *(f32x4*)(G1 + (size_t)r * EFF + c) = v;
        else { const f32x4 a = *(const f32x4*)(G1 + (size_t)r * EFF + c); st4bf(Hout + (size_t)r * EFF + c, (f32x4){siluf_(a.x) * v.x, siluf_(a.y) * v.y, siluf_(a.z) * v.z, siluf_(a.w) * v.w}); }
    }
};
struct FMoe2 {
    MoeCtx m; const bf16_t* Hin; const float* W; bf16_t* Y;
    __device__ __forceinline__ int K() const { return EFF; }
    __device__ __forceinline__ int ldb() const { return D; }
    __device__ __forceinline__ bool tile_active(int row0) const { return (unsigned)row0 < m.base[NEXP]; }
    __device__ __forceinline__ const float* b_ptr(int row0) const { return W + (size_t)moe_expert_of(m.base, (unsigned)row0) * EFF * D; }
    __device__ __forceinline__ const bf16_t* a_row(int r) const { return Hin + (size_t)r * EFF; }
    __device__ __forceinline__ void epi(int r, int c, f32x4 v) const { st4bf(Y + (size_t)r * D + c, v); }
};
}

struct Ptrs {
    const float *x, *c, *ctx, *c_ctx, *w_ada, *b_ada, *g_mix, *g_ffn, *w_in, *w_s, *b_s, *g_sgu, *decay, *w_pa, *w_pb, *w_out, *w_group, *b_group, *w_er, *b_er, *w1, *w3, *w2, *g_final;
    float* out; unsigned char* ws;
    unsigned* ctl; float* mod; float* cres; float* rot; bf16_t* h; bf16_t* P; bf16_t* KV;
    int *tok_e, *tok_p; float* tok_w; int* list;
};
__host__ __device__ static inline Ptrs make_ptrs(void* const* d_in, void* d_out, void* d_ws) {
    Ptrs p{}; const float* const* in = (const float* const*)d_in;
    p.x = in[0]; p.c = in[1]; p.ctx = in[2]; p.c_ctx = in[3]; p.w_ada = in[4]; p.b_ada = in[5]; p.g_mix = in[6]; p.g_ffn = in[7]; p.w_in = in[8]; p.w_s = in[9]; p.b_s = in[10]; p.g_sgu = in[11];
    p.decay = in[12]; p.w_pa = in[13]; p.w_pb = in[14]; p.w_out = in[15]; p.w_group = in[16]; p.b_group = in[17]; p.w_er = in[18]; p.b_er = in[19]; p.w1 = in[20]; p.w3 = in[21]; p.w2 = in[22]; p.g_final = in[23];
    p.out = (float*)d_out; p.ws = (unsigned char*)d_ws;
    p.ctl = (unsigned*)(p.ws + WS_CTL); p.mod = (float*)(p.ws + WS_MOD); p.cres = (float*)(p.ws + WS_CTXRES); p.rot = (float*)(p.ws + WS_ROT);
    p.h = (bf16_t*)(p.ws + WS_H); p.P = (bf16_t*)(p.ws + WS_P); p.KV = (bf16_t*)(p.ws + WS_KV);
    p.tok_e = (int*)(p.ws + WS_TAB + TAB_TOKE); p.tok_p = (int*)(p.ws + WS_TAB + TAB_TOKP); p.tok_w = (float*)(p.ws + WS_TAB + TAB_TOKW); p.list = (int*)(p.ws + WS_TAB + TAB_LIST);
    return p;
}

#define GAS __attribute__((address_space(1)))
#define LAS __attribute__((address_space(3)))
constexpr int NWAVES = 8;
constexpr int LDS_BYTES = 155648;
constexpr int LDSCTL_OFF = 154624;
constexpr int LDS_BASE_OFF = LDSCTL_OFF;
constexpr int LDS_MISC_OFF = LDSCTL_OFF + 512;

#define XB_TMO      128
#define XB_XCNT(j)  (256  + 64 * (j))
#define XB_XSUB(j)  (1280 + 64 * (j))
#define XB_XGEN(j)  (2304 + 64 * (j))
#define XB_TOP      3328
#define XB_TOPGEN   3392
#define XCD_BAR_WORDS 3456
#define XB_SPIN_CAP (1u << 24)
__device__ __forceinline__ unsigned xb_ld(unsigned* p)              { return __hip_atomic_load(p, __ATOMIC_RELAXED, __HIP_MEMORY_SCOPE_AGENT); }
__device__ __forceinline__ unsigned xb_add(unsigned* p, unsigned v) { return __hip_atomic_fetch_add(p, v, __ATOMIC_RELAXED, __HIP_MEMORY_SCOPE_AGENT); }
__device__ __forceinline__ unsigned xb_xcc_id() { return (unsigned)__builtin_amdgcn_s_getreg((3 << 11) | 20) & 0xFu; }
#define XB_SPIN(cond, bar) do { unsigned _sp = 0; while (cond) { __builtin_amdgcn_s_sleep(1); \
    if ((++_sp & 255u) == 0u) { if (xb_ld(&(bar)[XB_TMO])) break; if (_sp > XB_SPIN_CAP) { atomicAdd(&(bar)[XB_TMO], 1u); break; } } } } while (0)
struct XcdBarrier { unsigned* bar; unsigned x; volatile LAS unsigned* st; };
__device__ __forceinline__ XcdBarrier xcd_barrier_post(unsigned* bar, volatile LAS unsigned* st) {
    XcdBarrier b; b.bar = bar; b.x = xb_xcc_id(); b.st = st;
    if (threadIdx.x == 0) (void)xb_add(&bar[XB_XCNT(b.x)], 1u);
    return b;
}
__device__ __forceinline__ void xcd_barrier_complete(unsigned* bar, unsigned x, unsigned& nloc, unsigned& nx) {
    const unsigned G = gridDim.x * gridDim.y * gridDim.z;
    unsigned sum, cnt, mine, sp = 0u;
    for (;;) {
        sum = 0u; cnt = 0u; mine = 0u;
#pragma unroll
        for (unsigned j = 0; j < 16; ++j) { const unsigned c = xb_ld(&bar[XB_XCNT(j)]); sum += c; cnt += (c > 0u) ? 1u : 0u; mine = (j == x) ? c : mine; }
        if (sum == G) break;
        __builtin_amdgcn_s_sleep(1);
        if ((++sp & 255u) == 0u) { if (xb_ld(&bar[XB_TMO])) break; if (sp > XB_SPIN_CAP) { atomicAdd(&bar[XB_TMO], 1u); break; } }
    }
    nloc = mine > 0u ? mine : 1u; nx = cnt > 0u ? cnt : 1u;
}
__device__ __forceinline__ void xcd_barrier(const XcdBarrier& b) {
    asm volatile("s_waitcnt vmcnt(0)" ::: "memory");
    __syncthreads();
    if (threadIdx.x == 0) {
        unsigned* bar = b.bar;
        __builtin_amdgcn_s_waitcnt(0);
        unsigned nloc = b.st[0], nx = b.st[1];
        if (nloc == 0u) { xcd_barrier_complete(bar, b.x, nloc, nx); b.st[0] = nloc; b.st[1] = nx; }
        const unsigned old = xb_add(&bar[XB_XSUB(b.x)], 1u);
        const unsigned gen = old / nloc;
        if (old + 1u == (gen + 1u) * nloc) {
            __builtin_amdgcn_fence(__ATOMIC_RELEASE, "agent");
            asm volatile("s_waitcnt vmcnt(0)" ::: "memory");
            const unsigned og = xb_add(&bar[XB_TOP], 1u);
            const unsigned tg = og / nx;
            if (og + 1u == (tg + 1u) * nx) xb_add(&bar[XB_TOPGEN], 1u);
            else XB_SPIN(xb_ld(&bar[XB_TOPGEN]) == tg, bar);
            __builtin_amdgcn_fence(__ATOMIC_ACQUIRE, "agent");
            xb_add(&bar[XB_XGEN(b.x)], 1u);
            asm volatile("s_waitcnt vmcnt(0)" ::: "memory");
        } else {
            XB_SPIN(xb_ld(&bar[XB_XGEN(b.x)]) == gen, bar);
            __builtin_amdgcn_fence(__ATOMIC_ACQUIRE, "agent");
            asm volatile("s_waitcnt vmcnt(0)" ::: "memory");
        }
    }
    __syncthreads();
}
__device__ __forceinline__ int router_perm_k(int idx) { return 4 * (idx & 63) + ((idx >> 6) & 3) + 256 * (idx >> 8); }
__device__ __forceinline__ void norm2_phase(int tid, char* lds, int bid, int G, const float* xs, const float* cs, const float* gvec, const float* mod_l, bf16_t* h,
                                            const float* w_group, const float* b_group, const float* w_er, const float* b_er,
                                            unsigned* cnt, int* tok_e, int* tok_p, float* tok_w, int* list, int with_ctx) {
    f32x4* Wg4 = (f32x4*)lds; f32x4* We4 = (f32x4*)(lds + 16384);
    __syncthreads();
    for (int idx = tid; idx < 1024; idx += 512) Wg4[idx] = *(const f32x4*)(w_group + (size_t)router_perm_k(idx) * 4);
    for (int i = tid; i < 8192; i += 512) { const int idx = i >> 3, c = i & 7, g = c >> 1, hf = c & 1;
        We4[(g * 2 + hf) * 1024 + idx] = *(const f32x4*)(w_er + (size_t)router_perm_k(idx) * 32 + c * 4); }
    __syncthreads();
    const int lane = tid & 63, wv = tid >> 6;
    const f32x4 bg = *(const f32x4*)b_group;
    for (int R = bid * 8 + wv; R < MT; R += G * 8) {
        const RowInfo ri = rinfo(R); if (ri.is_ctx && !with_ctx) continue;
        const float* src = ri.is_ctx ? cs + (size_t)ri.nat * D : xs + (size_t)ri.nat * D;
        f32x4 v[4]; nv::norm_mod_row(src, gvec, mod_l + ri.mj * 6144 + 4 * 1024, mod_l + ri.mj * 6144 + 3 * 1024, lane, v);
        nv::store_row_bf16(h + (size_t)R * D, lane, v);
        f32x4 gl = (f32x4){0.f, 0.f, 0.f, 0.f};
#pragma unroll
        for (int j = 0; j < 4; ++j)
#pragma unroll
            for (int e = 0; e < 4; ++e) gl += Wg4[(j * 4 + e) * 64 + lane] * v[j][e];
        gl.x = wave_sum(gl.x) + bg.x; gl.y = wave_sum(gl.y) + bg.y; gl.z = wave_sum(gl.z) + bg.z; gl.w = wave_sum(gl.w) + bg.w;
        int gs = 0; float gt = gl.x;
        if (gl.y > gt) { gt = gl.y; gs = 1; } if (gl.z > gt) { gt = gl.z; gs = 2; } if (gl.w > gt) { gt = gl.w; gs = 3; }
        const float pg = 1.0f / (expf(gl.x - gt) + expf(gl.y - gt) + expf(gl.z - gt) + expf(gl.w - gt));
        gs = __builtin_amdgcn_readfirstlane(gs);
        f32x4 ea = (f32x4){0.f, 0.f, 0.f, 0.f}, eb = ea;
        const f32x4* Wa = We4 + (gs * 2) * 1024; const f32x4* Wb = Wa + 1024;
#pragma unroll
        for (int j = 0; j < 4; ++j)
#pragma unroll
            for (int e = 0; e < 4; ++e) { ea += Wa[(j * 4 + e) * 64 + lane] * v[j][e]; eb += Wb[(j * 4 + e) * 64 + lane] * v[j][e]; }
        const f32x4 be0 = *(const f32x4*)(b_er + gs * 8), be1 = *(const f32x4*)(b_er + gs * 8 + 4);
        float eg[8];
        eg[0] = wave_sum(ea.x) + be0.x; eg[1] = wave_sum(ea.y) + be0.y; eg[2] = wave_sum(ea.z) + be0.z; eg[3] = wave_sum(ea.w) + be0.w;
        eg[4] = wave_sum(eb.x) + be1.x; eg[5] = wave_sum(eb.y) + be1.y; eg[6] = wave_sum(eb.z) + be1.z; eg[7] = wave_sum(eb.w) + be1.w;
        int i0 = 0; float e0 = eg[0];
#pragma unroll
        for (int j = 1; j < 8; ++j) if (eg[j] > e0) { e0 = eg[j]; i0 = j; }
        int i1 = -1; float e1 = -3.0e38f;
#pragma unroll
        for (int j = 0; j < 8; ++j) if (j != i0 && eg[j] > e1) { e1 = eg[j]; i1 = j; }
        const float x1 = expf(e1 - e0), w0 = pg / (1.0f + x1), w1 = pg * x1 / (1.0f + x1);
        if (lane == 0) {
            const int ex = gs * 8 + i0, ey = gs * 8 + i1;
            const int pa = (int)atomicAdd(cnt + ex, 1u), pb = (int)atomicAdd(cnt + ey, 1u);
            list[(size_t)ex * MT + pa] = R; list[(size_t)ey * MT + pb] = R;
            tok_e[2 * R] = ex; tok_e[2 * R + 1] = ey; tok_p[2 * R] = pa; tok_p[2 * R + 1] = pb; tok_w[2 * R] = w0; tok_w[2 * R + 1] = w1;
        }
    }
}
__device__ __forceinline__ void fast_prologue(char* lds, const Ptrs& p, int bid, int G) {}
constexpr int PH_PER_LAYER = 16, N_PRO = 2, N_PHASES = N_PRO + DEPTH * PH_PER_LAYER;
struct Args { const float* in[24]; float* out; unsigned char* ws; int ph_lo, ph_hi; };

#ifndef FAST_GEMM_IN
#define FAST_GEMM_IN 0
#endif
#ifndef FAST_MERGE
#define FAST_MERGE 0
#endif
#ifndef FAST_OUT
#define FAST_OUT 0
#endif
#ifndef FAST_MOE
#define FAST_MOE 0
#endif
#ifndef FAST_SGU
#define FAST_SGU 0
#endif
#ifndef FAST_RET
#define FAST_RET 0
#endif

#define TID_HERE const int tid = ({ int t_ = threadIdx.x; asm volatile("" : "+v"(t_)); t_; })
__global__ void __launch_bounds__(NWAVES * 64, 2) mega(Args args) {
    extern __shared__ __attribute__((aligned(16))) unsigned char lds_raw[];
    char* lds = (char*)lds_raw;
    const int G = gridDim.x, bid = blockIdx.x;
    const Ptrs p = make_ptrs((void* const*)args.in, args.out, args.ws);
    for (int u = threadIdx.x; u < (LDS_BYTES - LDSCTL_OFF) / 4; u += NWAVES * 64) ((LAS unsigned*)(lds_raw + LDSCTL_OFF))[u] = 0u;
    __syncthreads();
    unsigned* lbase = (unsigned*)(lds + LDS_BASE_OFF);
    XcdBarrier bar = xcd_barrier_post(p.ctl + CW_BAR, (volatile LAS unsigned*)(lds_raw + LDS_MISC_OFF) + 8);

    for (int ph = args.ph_lo; ph < args.ph_hi; ++ph) {
        if (ph == 0) {
            TID_HERE;
            for (int vb = bid; vb < 192; vb += G) nv::b_mod(tid, lds, vb, p.c, p.c_ctx, p.w_ada, p.b_ada, p.mod);
            for (int vb = bid; vb < SEQ * 64 / 512; vb += G) nv::b_rot(tid, vb, p.rot);
            fast_prologue(lds, p, bid, G);
        } else if (ph == 1) {
            TID_HERE;
            for (int vb = bid; vb < MT / 8; vb += G) nv::b_norm1(tid, vb, p.x, p.ctx, p.g_mix, p.mod, p.h);
        } else {
            const int q = ph - N_PRO, l = q / PH_PER_LAYER, r = q % PH_PER_LAYER;
            const float* mod_l = p.mod + (size_t)l * 9 * 6144;
            if (r < 12) {
                const int g = r / 6, st = r % 6;
                const int Mrows = l == 0 ? GR : GX;
                if (st == 0) {
                    TID_HERE;
#if FAST_GEMM_IN
                    fast_gemm_in(lds, p, l, g);
#else
                    nv::FDense<EpiIn> f{}; f.A = p.h + (size_t)g * GR * D; f.lda = D; f.B = p.w_in + (size_t)l * D * DIN; f.ldb_ = DIN; f.K_ = D; f.e.P = p.P; f.e.rot = p.rot;
                    for (int vb = bid; vb < (DIN / 64) * (GR / 128); vb += G) nv::b_gemm(tid, lds, vb % (DIN / 64), vb / (DIN / 64), f);
#endif
                } else if (st == 1) {
                    TID_HERE;
#if FAST_SGU
                    fast_sgu(lds, p, l);
#else
                    const int chunks = GB * 32 + (l == 0 ? GB * 2 : 0);
                    for (int vb = bid; vb < chunks * 8; vb += G) nv::b_sgu(tid, lds, vb >> 3, vb & 7, p.P, p.w_s + (size_t)l * 8 * 128 * 128, p.b_s + l * 8 * 128, p.g_sgu + l * 1024);
#endif
#if FAST_RET
                    fast_ret_kv(lds, p, l);
#endif
                } else if (st == 2) {
                    TID_HERE; (void)tid;
#if FAST_RET
                    fast_ret_scan(lds, p, l);
#endif
                } else if (st == 3) {
                    TID_HERE;
#if FAST_RET
                    fast_ret_out(lds, p, l);
#else
                    for (int vb = bid; vb < (SEQ / 32) * NHEAD * GB; vb += G) nv::b_ret(tid, lds, vb % (SEQ / 32), (vb / (SEQ / 32)) % NHEAD, vb / ((SEQ / 32) * NHEAD), p.P, p.decay + l * 8, 0);
                    if (l == 0) for (int vb = bid; vb < (CTXL / 32) * NHEAD * GB; vb += G) nv::b_ret(tid, lds, vb % (CTXL / 32), (vb / (CTXL / 32)) % NHEAD, vb / ((CTXL / 32) * NHEAD), p.P, p.decay + l * 8, 1);
#endif
                } else if (st == 4) {
                    TID_HERE;
#if FAST_MERGE
                    fast_merge(lds, p, l, Mrows);
#else
                    nv::FDense<EpiMergeA> fa{}; fa.A = p.P + C_U; fa.lda = DIN; fa.B = p.w_pa + (size_t)l * D * D; fa.ldb_ = D; fa.K_ = D; fa.e.P = p.P;
                    nv::FDense<EpiMergeB> fb{}; fb.A = p.P + C_GR; fb.lda = DIN; fb.B = p.w_pb + (size_t)l * D * D; fb.ldb_ = D; fb.K_ = D; fb.e.P = p.P;
                    for (int vb = bid; vb < (D / 64) * (Mrows / 128); vb += G) { nv::b_gemm(tid, lds, vb % (D / 64), vb / (D / 64), fa); nv::b_gemm(tid, lds, vb % (D / 64), vb / (D / 64), fb); }
#endif
                } else {
                    TID_HERE;
#if FAST_OUT
                    fast_out(lds, p, l, g, Mrows);
#else
                    nv::FDense<EpiOut> f{}; f.A = p.P + C_GA; f.lda = DIN; f.B = p.w_out + (size_t)l * D * D; f.ldb_ = D; f.K_ = D;
                    f.e.xsrc = l == 0 ? p.x : p.out; f.e.csrc = l == 0 ? p.ctx : p.cres; f.e.xdst = p.out; f.e.cdst = p.cres; f.e.mod_l = mod_l; f.e.g = g;
                    for (int vb = bid; vb < (D / 64) * (Mrows / 128); vb += G) nv::b_gemm(tid, lds, vb % (D / 64), vb / (D / 64), f);
#endif
                }
            } else {
                const int st = r - 12;
                unsigned* cnt = p.ctl + CW_CNT + l * 32;
                bf16_t* Hb = (bf16_t*)(p.ws + WS_MOEH); float* G1 = (float*)(p.ws + WS_MOEY); bf16_t* Y = (bf16_t*)(p.ws + WS_MOEY);
                if (st == 0) {
                    TID_HERE;
                    norm2_phase(tid, lds, bid, G, p.out, p.cres, p.g_ffn + l * D, mod_l, p.h, p.w_group + l * D * 4, p.b_group + l * 4, p.w_er + l * D * 32, p.b_er + l * 32, cnt, p.tok_e, p.tok_p, p.tok_w, p.list, l == 0 ? 1 : 0);
                } else if (st == 1) {
                    TID_HERE;
                    nv::b_offsets(tid, cnt, lbase);
#if FAST_MOE
                    fast_moe1(lds, p, l, cnt, lbase);
#else
                    nv::MoeCtx m{cnt, lbase, p.list};
                    nv::FMoe1 f1{}; f1.m = m; f1.h2 = p.h; f1.W = p.w1 + (size_t)l * NEXP * D * EFF; f1.G1 = G1; f1.Hout = Hb; f1.second = 0;
                    nv::FMoe1 f3 = f1; f3.W = p.w3 + (size_t)l * NEXP * D * EFF; f3.second = 1;
                    for (int vb = bid; vb < (EFF / 64) * (SLOT_CAP / 128); vb += G) { nv::b_gemm(tid, lds, vb % (EFF / 64), vb / (EFF / 64), f1); nv::b_gemm(tid, lds, vb % (EFF / 64), vb / (EFF / 64), f3); }
#endif
                } else if (st == 2) {
                    TID_HERE;
                    nv::b_offsets(tid, cnt, lbase);
#if FAST_MOE
                    fast_moe2(lds, p, l, cnt, lbase);
#else
                    nv::MoeCtx m{cnt, lbase, p.list};
                    nv::FMoe2 f2{}; f2.m = m; f2.Hin = Hb; f2.W = p.w2 + (size_t)l * NEXP * EFF * D; f2.Y = Y;
                    for (int vb = bid; vb < (D / 64) * (SLOT_CAP / 128); vb += G) nv::b_gemm(tid, lds, vb % (D / 64), vb / (D / 64), f2);
#endif
                } else {
                    TID_HERE;
                    nv::b_offsets(tid, cnt, lbase);
                    const int last = (l == DEPTH - 1);
                    for (int vb = bid; vb < MT / 8; vb += G)
                        nv::b_combine(tid, vb, p.out, p.cres, Y, lbase, p.tok_e, p.tok_p, p.tok_w, mod_l, l == 0 ? 1 : 0, last, last ? p.g_mix : p.g_mix + (l + 1) * D, last ? p.mod : p.mod + (size_t)(l + 1) * 9 * 6144, p.h, p.g_final);
                }
            }
        }
        if (ph + 1 < args.ph_hi) xcd_barrier(bar);
    }
}

extern "C" void kernel_launch(void* const* d_in, const int* in_sizes, int n_in, void* d_out, int out_size, void* d_ws, size_t ws_size, hipStream_t stream) {
    static int grid = 0;
    if (grid == 0) {
        if (n_in != 24 || out_size != TX * D || ws_size < WS_END) { fprintf(stderr, "kernel_launch: unexpected sizes n_in %d out %d ws %zu\n", n_in, out_size, ws_size); grid = -1; return; }
        int dev = 0, cus = 0, per_cu = 0;
        if (hipGetDevice(&dev) != hipSuccess || hipDeviceGetAttribute(&cus, hipDeviceAttributeMultiprocessorCount, dev) != hipSuccess) { grid = -1; return; }
        if (hipFuncSetAttribute((const void*)mega, hipFuncAttributeMaxDynamicSharedMemorySize, LDS_BYTES) != hipSuccess) { fprintf(stderr, "kernel_launch: hipFuncSetAttribute failed\n"); grid = -1; return; }
        if (hipOccupancyMaxActiveBlocksPerMultiprocessor(&per_cu, (const void*)mega, NWAVES * 64, LDS_BYTES) != hipSuccess || per_cu < 1) fprintf(stderr, "kernel_launch: occupancy query says %d\n", per_cu);
        (void)hipGetLastError();
        grid = cus;
    }
    if (grid < 0) return;
    (void)hipMemsetAsync((char*)d_ws + WS_CTL, 0, CTL_BYTES, stream);
    Args a{};
    for (int i = 0; i < 24; ++i) a.in[i] = (const float*)d_in[i];
    a.out = (float*)d_out; a.ws = (unsigned char*)d_ws;
#ifndef N_LAUNCH_SPLIT
    a.ph_lo = 0; a.ph_hi = N_PHASES;
    hipLaunchKernelGGL(mega, dim3(grid), dim3(NWAVES * 64), LDS_BYTES, stream, a);
#else
    for (int ph = 0; ph < N_PHASES; ++ph) { a.ph_lo = ph; a.ph_hi = ph + 1; hipLaunchKernelGGL(mega, dim3(grid), dim3(NWAVES * 64), LDS_BYTES, stream, a); }
#endif
}
```

```cpp
#define FAST_GEMM_IN 1
#define FAST_MERGE 1
#define FAST_OUT 1
#define FAST_MOE 1
#include <hip/hip_runtime.h>
#include <cstdio>
#include <cstdint>
#include <cmath>

typedef unsigned short bf16_t;
typedef float f32x4 __attribute__((ext_vector_type(4)));
typedef float f32x2 __attribute__((ext_vector_type(2)));
typedef unsigned u32x4 __attribute__((ext_vector_type(4)));
typedef unsigned u32x2 __attribute__((ext_vector_type(2)));
typedef short bf16x8 __attribute__((ext_vector_type(8)));

constexpr int D = 1024, NB = 8, SEQ = 4096, CTXL = 256, DEPTH = 2;
constexpr int TX = NB * SEQ, TC = NB * CTXL, MT = TX + TC;
constexpr int DIN = 7168;
constexpr int C_U = 0, C_VA = 1024, C_Q = 2048, C_K = 2560, C_V = 3072, C_GR = 4096, C_GA = 5120, C_GB = 6144;
constexpr int NGRP = 2, GB = NB / NGRP;
constexpr int GX = GB * SEQ, GC = GB * CTXL, GR = GX + GC;
constexpr int NHEAD = 4, DK = 128, DV = 256, CH = 128;
constexpr int NEXP = 32, EFF = 512;
constexpr int SLOT_CAP = 2 * MT + NEXP * 256;
constexpr float EPS = 1e-6f;

constexpr size_t MiB = 1u << 20;
constexpr size_t WS_CTL = 0;
constexpr size_t CTL_BYTES = 1 * MiB;
constexpr size_t WS_MOD = 1 * MiB;
constexpr size_t WS_TAB = 2 * MiB;
constexpr size_t WS_CTXRES = 8 * MiB;
constexpr size_t WS_WIN = 16 * MiB;
constexpr size_t WS_WPROJ = 44 * MiB;
constexpr size_t WS_WS = 56 * MiB;
constexpr size_t WS_ROT = 57 * MiB;
constexpr size_t WS_WMOE = 60 * MiB;
constexpr size_t WS_H = 156 * MiB;
constexpr size_t WS_KV = 224 * MiB;
constexpr size_t WS_P = 292 * MiB;
constexpr size_t WS_END = 530 * MiB;
constexpr size_t P_BYTES = (size_t)GR * DIN * 2;
static_assert(WS_P + P_BYTES <= WS_END, "ws map");
constexpr size_t WS_MOEH = WS_P;
constexpr size_t WS_MOEY = WS_P + 76 * MiB;
static_assert((size_t)SLOT_CAP * EFF * 2 <= 76 * MiB && WS_MOEY + (size_t)SLOT_CAP * D * 2 <= WS_END, "moe map");

constexpr size_t TAB_TOKE = 0;
constexpr size_t TAB_TOKP = TAB_TOKE + (size_t)MT * 8;
constexpr size_t TAB_TOKW = TAB_TOKP + (size_t)MT * 8;
constexpr size_t TAB_LIST = 1 * MiB;
static_assert(TAB_TOKW + (size_t)MT * 8 <= TAB_LIST && TAB_LIST + (size_t)NEXP * MT * 4 <= 6 * MiB, "tab map");
constexpr int CW_CNT = 64;
constexpr int CW_BASE = 256;
constexpr int CW_BAR = 4096;

__device__ __forceinline__ float bf2f(bf16_t v) { return __uint_as_float(((unsigned)v) << 16); }
__device__ __forceinline__ unsigned f2bf(float f) { unsigned u = __float_as_uint(f); return (u + 0x7fffu + ((u >> 16) & 1u)) >> 16; }
__device__ __forceinline__ unsigned pk2(float lo, float hi) { return f2bf(lo) | (f2bf(hi) << 16); }
__device__ __forceinline__ float sigmoidf_(float x) { return 1.0f / (1.0f + __expf(-x)); }
__device__ __forceinline__ float siluf_(float x) { return x / (1.0f + __expf(-x)); }
__device__ __forceinline__ float geluf_(float x) { const float z = 0.7978845608028654f * (x + 0.044715f * x * x * x); return x / (1.0f + __expf(-2.0f * z)); }
__device__ __forceinline__ float wave_sum(float v) {
#pragma unroll
    for (int o = 1; o < 64; o <<= 1) v += __shfl_xor(v, o);
    return v;
}
struct RowInfo { int b, is_ctx, nat, mj; };
__device__ __forceinline__ RowInfo rinfo(int R) {
    RowInfo r; const int g = R / GR, loc = R - g * GR;
    if (loc < GX) { r.b = g * GB + (loc >> 12); r.is_ctx = 0; r.nat = r.b * SEQ + (loc & 4095); r.mj = r.b; }
    else { const int lc = loc - GX; r.b = g * GB + (lc >> 8); r.is_ctx = 1; r.nat = r.b * CTXL + (lc & 255); r.mj = 8; }
    return r;
}
__device__ __forceinline__ void st4bf(bf16_t* p, f32x4 v) { u32x2 w; w.x = pk2(v.x, v.y); w.y = pk2(v.z, v.w); *(u32x2*)p = w; }
__device__ __forceinline__ f32x4 ld4bf(const bf16_t* p) { const u32x2 w = *(const u32x2*)p; return (f32x4){bf2f((bf16_t)(w.x & 0xffffu)), bf2f((bf16_t)(w.x >> 16)), bf2f((bf16_t)(w.y & 0xffffu)), bf2f((bf16_t)(w.y >> 16))}; }

struct EpiIn {
    bf16_t* P; const float* rot;
    __device__ __forceinline__ void operator()(int row, int col0, f32x4 v) const {
        if (col0 < C_Q) { v = (f32x4){geluf_(v.x), geluf_(v.y), geluf_(v.z), geluf_(v.w)}; }
        else if (col0 < C_V) {
            if (col0 >= C_K) v = v * 0.08838834764831845f;
            if (row < GX) {
                const int n = row & (SEQ - 1), i2 = ((col0 - C_Q) & 127) >> 1;
                const f32x4 cs = *(const f32x4*)(rot + ((size_t)n * 64 + i2) * 2);
                v = (f32x4){v.x * cs.x - v.y * cs.y, v.x * cs.y + v.y * cs.x, v.z * cs.z - v.w * cs.w, v.z * cs.w + v.w * cs.z};
            }
        }
        else if (col0 < C_GR) { }
        else if (col0 < C_GA) { v = (f32x4){siluf_(v.x), siluf_(v.y), siluf_(v.z), siluf_(v.w)}; }
        else { v = (f32x4){sigmoidf_(v.x), sigmoidf_(v.y), sigmoidf_(v.z), sigmoidf_(v.w)}; }
        st4bf(P + (size_t)row * DIN + col0, v);
    }
};
struct EpiMergeA {
    bf16_t* P;
    __device__ __forceinline__ void operator()(int row, int col0, f32x4 v) const {
        bf16_t* p = P + (size_t)row * DIN + C_GA + col0; st4bf(p, ld4bf(p) * v);
    }
};
struct EpiMergeB {
    bf16_t* P;
    __device__ __forceinline__ void operator()(int row, int col0, f32x4 v) const {
        bf16_t* p = P + (size_t)row * DIN + C_GA + col0; st4bf(p, ld4bf(p) + ld4bf(P + (size_t)row * DIN + C_GB + col0) * v);
    }
};
struct EpiOut {
    const float* xsrc; const float* csrc; float* xdst; float* cdst; const float* mod_l; int g;
    __device__ __forceinline__ void operator()(int row, int col0, f32x4 v) const {
        const RowInfo ri = rinfo(g * GR + row);
        const size_t off = (size_t)ri.nat * D + col0;
        const f32x4 gt = *(const f32x4*)(mod_l + ri.mj * 6144 + 2 * 1024 + col0);
        const float* xs_ = xsrc; const float* cs_ = csrc; float* xd_ = xdst; float* cd_ = cdst;
        const float* src = ri.is_ctx ? cs_ : xs_; float* dst = ri.is_ctx ? cd_ : xd_;
        *(f32x4*)(dst + off) = *(const f32x4*)(src + off) + gt * v;
    }
};
namespace nv {

__device__ __forceinline__ void b_mod(int tid, char* lds, int vb, const float* c, const float* c_ctx, const float* w_ada, const float* b_ada, float* mod) {
    float (*sc)[1024] = (float (*)[1024])lds;
    float (*red)[9][64] = (float (*)[9][64])(lds + 9 * 1024 * 4);
    const int t = tid, l = vb / 96, n0 = (vb % 96) * 64;
    __syncthreads();
    for (int i = t; i < 9 * 1024; i += 512) { const int j = i >> 10, k = i & 1023; const float v = j < 8 ? c[j * 1024 + k] : c_ctx[k]; sc[j][k] = v / (1.0f + expf(-v)); }
    __syncthreads();
    const int col = t & 63, ks = t >> 6;
    float acc[9];
#pragma unroll
    for (int j = 0; j < 9; ++j) acc[j] = 0.f;
    const float* w = w_ada + (size_t)l * 1024 * 6144 + n0 + col;
    for (int k = ks * 128; k < ks * 128 + 128; ++k) {
        const float wv = w[(size_t)k * 6144];
#pragma unroll
        for (int j = 0; j < 9; ++j) acc[j] += sc[j][k] * wv;
    }
#pragma unroll
    for (int j = 0; j < 9; ++j) red[ks][j][col] = acc[j];
    __syncthreads();
    for (int i = t; i < 9 * 64; i += 512) {
        const int j = i >> 6, cc = i & 63; float s = 0.f;
#pragma unroll
        for (int q = 0; q < 8; ++q) s += red[q][j][cc];
        mod[(size_t)(l * 9 + j) * 6144 + n0 + cc] = s + b_ada[l * 6144 + n0 + cc];
    }
}

__device__ __forceinline__ void b_rot(int tid, int vb, float* rot) {
    const int i = vb * 512 + tid; if (i >= SEQ * 64) return;
    const int n = i >> 6, i2 = i & 63;
    const float inv = powf(10000.0f, -(float)(i2 & 31) / 32.0f);
    const float pos = (i2 < 32) ? (float)(n >> 6) : (float)(n & 63);
    const float ang = pos * inv; float s, c; sincosf(ang, &s, &c);
    rot[2 * i] = c; rot[2 * i + 1] = s;
}

__device__ __forceinline__ void norm_mod_row(const float* src, const float* gvec, const float* sc, const float* sh, int lane, f32x4 (&v)[4]) {
    float ss = 0.f;
#pragma unroll
    for (int j = 0; j < 4; ++j) { v[j] = *(const f32x4*)(src + 4 * lane + 256 * j); ss += (v[j].x * v[j].x + v[j].y * v[j].y) + (v[j].z * v[j].z + v[j].w * v[j].w); }
    const float rstd = 1.0f / sqrtf(wave_sum(ss) * (1.0f / 1024.0f) + EPS);
#pragma unroll
    for (int j = 0; j < 4; ++j) {
        const f32x4 g = *(const f32x4*)(gvec + 4 * lane + 256 * j), s1 = *(const f32x4*)(sc + 4 * lane + 256 * j), s0 = *(const f32x4*)(sh + 4 * lane + 256 * j);
        v[j] = (v[j] * rstd * g) * (1.0f + s1) + s0;
    }
}
__device__ __forceinline__ void store_row_bf16(bf16_t* dst, int lane, const f32x4 (&v)[4]) {
#pragma unroll
    for (int j = 0; j < 4; ++j) { u32x2 w; w.x = pk2(v[j].x, v[j].y); w.y = pk2(v[j].z, v[j].w); *(u32x2*)(dst + 4 * lane + 256 * j) = w; }
}

__device__ __forceinline__ void b_norm1(int tid, int vb, const float* xs, const float* cs, const float* gvec, const float* mod_l, bf16_t* h) {
    const int lane = tid & 63, R = vb * 8 + (tid >> 6); if (R >= MT) return;
    const RowInfo ri = rinfo(R);
    const float* src = ri.is_ctx ? cs + (size_t)ri.nat * D : xs + (size_t)ri.nat * D;
    f32x4 v[4]; norm_mod_row(src, gvec, mod_l + ri.mj * 6144 + 1024, mod_l + ri.mj * 6144 + 0, lane, v);
    store_row_bf16(h + (size_t)R * D, lane, v);
}

__device__ __forceinline__ void b_offsets(int tid, const unsigned* cnt, unsigned* base) {
    __syncthreads();
    if (tid == 0) { unsigned b = 0; for (int e = 0; e < NEXP; ++e) { base[e] = b; b += ((__hip_atomic_load(cnt + e, __ATOMIC_RELAXED, __HIP_MEMORY_SCOPE_AGENT) + 255u) / 256u) * 256u; } base[NEXP] = b; }
    __syncthreads();
}

template <class F> __device__ __forceinline__ void b_gemm(int tid, char* lds, int bx, int by, const F f) {
    float (*As)[132] = (float (*)[132])lds;
    float (*Bs)[68] = (float (*)[68])(lds + 16 * 132 * 4);
    const int t = tid, row0 = by * 128, col0 = bx * 64;
    if (!f.tile_active(row0)) return;
    const float* B = f.b_ptr(row0); const int ldb = f.ldb(), K = f.K();
    const int tm = t >> 4, tn = t & 15;
    float acc[4][4];
#pragma unroll
    for (int i = 0; i < 4; ++i)
#pragma unroll
        for (int j = 0; j < 4; ++j) acc[i][j] = 0.f;
    const int ar = t >> 2, ak = (t & 3) * 4;
    const bf16_t* arow = f.a_row(row0 + ar);
    const int bk = t >> 5, bn = (t & 31) * 2;
    for (int k0 = 0; k0 < K; k0 += 16) {
        const u32x2 av = *(const u32x2*)(arow + k0 + ak);
        As[ak + 0][ar] = bf2f((bf16_t)(av.x & 0xffffu)); As[ak + 1][ar] = bf2f((bf16_t)(av.x >> 16));
        As[ak + 2][ar] = bf2f((bf16_t)(av.y & 0xffffu)); As[ak + 3][ar] = bf2f((bf16_t)(av.y >> 16));
        const f32x2 bv = *(const f32x2*)(B + (size_t)(k0 + bk) * ldb + col0 + bn);
        Bs[bk][bn] = bv.x; Bs[bk][bn + 1] = bv.y;
        __syncthreads();
#pragma unroll
        for (int kk = 0; kk < 16; ++kk) {
            float a[4], b[4];
#pragma unroll
            for (int i = 0; i < 4; ++i) { a[i] = As[kk][tm * 4 + i]; b[i] = Bs[kk][tn * 4 + i]; }
#pragma unroll
            for (int i = 0; i < 4; ++i)
#pragma unroll
                for (int j = 0; j < 4; ++j) acc[i][j] += a[i] * b[j];
        }
        __syncthreads();
    }
#pragma unroll
    for (int i = 0; i < 4; ++i) f.epi(row0 + tm * 4 + i, col0 + tn * 4, (f32x4){acc[i][0], acc[i][1], acc[i][2], acc[i][3]});
}

__device__ __forceinline__ void b_sgu(int tid, char* lds, int c, int g, bf16_t* P, const float* w_s_l, const float* b_s_l, const float* g_sgu_l) {
    float* sm = (float*)lds;
    float* vn = sm; float* w = sm + 128 * 128; float* mu = w + 128 * 129; float* rs = mu + 128;
    const int t = tid, lane = t & 63, wv = t >> 6;
    __syncthreads();
    const int row0 = c < GB * 32 ? (c >> 5) * SEQ + (c & 31) * CH : GX + ((c - GB * 32) >> 1) * CTXL + ((c - GB * 32) & 1) * CH;
    for (int r = wv * 16; r < wv * 16 + 16; ++r) {
        const bf16_t* src = P + (size_t)(row0 + r) * DIN + C_VA; float s = 0.f, s2 = 0.f;
#pragma unroll
        for (int j = 0; j < 16; ++j) { const float x = bf2f(src[lane + 64 * j]); s += x; s2 += x * x; }
        s = wave_sum(s); s2 = wave_sum(s2);
        const float m = s * (1.0f / 1024.0f), var = s2 * (1.0f / 1024.0f) - m * m;
        if (lane == 0) { mu[r] = m; rs[r] = 1.0f / sqrtf(fmaxf(var, 0.f) + EPS); }
    }
    __syncthreads();
    for (int i = t; i < 128 * 128; i += 512) { const int q = i >> 7, cc = i & 127;
        vn[i] = (bf2f(P[(size_t)(row0 + q) * DIN + C_VA + g * 128 + cc]) - mu[q]) * rs[q] * g_sgu_l[g * 128 + cc];
        w[q * 129 + cc] = w_s_l[(size_t)g * 128 * 128 + i]; }
    __syncthreads();
    const int p = t >> 2, c0 = (t & 3) * 32;
    float acc[32];
#pragma unroll
    for (int j = 0; j < 32; ++j) acc[j] = 0.f;
    for (int q = 0; q < 128; ++q) { const float wq = w[p * 129 + q];
#pragma unroll
        for (int j = 0; j < 32; ++j) acc[j] += wq * vn[q * 128 + c0 + j]; }
    const float bs = b_s_l[g * 128 + p];
    bf16_t* dst = P + (size_t)(row0 + p) * DIN + C_U + g * 128 + c0;
#pragma unroll
    for (int j = 0; j < 32; ++j) dst[j] = (bf16_t)f2bf(bf2f(dst[j]) * (acc[j] + bs));
}

__device__ __forceinline__ void b_ret(int tid, char* lds, int bx, int hh, int lb, bf16_t* P, const float* decay_l, int is_ctx_seq) {
    float (*qs)[129] = (float (*)[129])lds;
    float (*ks)[129] = (float (*)[129])(lds + 32 * 129 * 4);
    bf16_t (*vs)[256] = (bf16_t (*)[256])(lds + 2 * 32 * 129 * 4);
    float (*ps)[33] = (float (*)[33])(lds + 2 * 32 * 129 * 4 + 32 * 256 * 2);
    const int t = tid, n0 = bx * 32;
    __syncthreads();
    const int N = is_ctx_seq ? CTXL : SEQ;
    const int seq_row0 = is_ctx_seq ? GX + lb * CTXL : lb * SEQ, ctx_row0 = GX + lb * CTXL;
    const float df = decay_l[hh], db = decay_l[4 + hh];
    const float lgf = -log1pf(expf(-df)), lgb = -log1pf(expf(-db));
    { const int r = t >> 4, c8 = (t & 15) * 8; const bf16_t* src = P + (size_t)(seq_row0 + n0 + r) * DIN + C_Q + hh * DK + c8;
#pragma unroll
      for (int j = 0; j < 8; ++j) qs[r][c8 + j] = bf2f(src[j]); }
    const int orow = t >> 4, e0 = (t & 15) * 16;
    const int sn = t >> 4, sm0 = (t & 15) * 2;
    float acc[16];
#pragma unroll
    for (int j = 0; j < 16; ++j) acc[j] = 0.f;
    const int n_ctx_tiles = is_ctx_seq ? 0 : CTXL / 32, n_tiles = n_ctx_tiles + N / 32;
    for (int tile = 0; tile < n_tiles; ++tile) {
        const bool from_ctx = tile < n_ctx_tiles;
        const int m0 = from_ctx ? tile * 32 : (tile - n_ctx_tiles) * 32;
        const int krow0 = from_ctx ? ctx_row0 + m0 : seq_row0 + m0;
        __syncthreads();
        { const int r = t >> 4, c8 = (t & 15) * 8; const bf16_t* src = P + (size_t)(krow0 + r) * DIN + C_K + hh * DK + c8;
#pragma unroll
          for (int j = 0; j < 8; ++j) ks[r][c8 + j] = bf2f(src[j]);
          const bf16_t* vsrc = P + (size_t)(krow0 + r) * DIN + C_V + hh * DV + (t & 15) * 16;
          *(u32x4*)&vs[r][(t & 15) * 16] = *(const u32x4*)vsrc; *(u32x4*)&vs[r][(t & 15) * 16 + 8] = *(const u32x4*)(vsrc + 8); }
        __syncthreads();
        float s0 = 0.f, s1 = 0.f;
#pragma unroll 8
        for (int d = 0; d < 128; ++d) { const float qv = qs[sn][d]; s0 += qv * ks[sm0][d]; s1 += qv * ks[sm0 + 1][d]; }
        const int n = n0 + sn;
#pragma unroll
        for (int u = 0; u < 2; ++u) { const int m = m0 + sm0 + u; float wgt;
            if (from_ctx) wgt = expf(lgf * (float)(n + CTXL - m)) + expf(lgb * (float)(N - n + m));
            else wgt = (m <= n) ? expf(lgf * (float)(n - m)) : expf(lgb * (float)(m - n));
            ps[sn][sm0 + u] = (u == 0 ? s0 : s1) * wgt; }
        __syncthreads();
#pragma unroll 4
        for (int mm = 0; mm < 32; ++mm) { const float pv = ps[orow][mm];
#pragma unroll
            for (int j = 0; j < 16; ++j) acc[j] += pv * bf2f(vs[mm][e0 + j]); }
    }
    float s = 0.f;
#pragma unroll
    for (int j = 0; j < 16; ++j) s += acc[j];
    s += __shfl_xor(s, 1); s += __shfl_xor(s, 2); s += __shfl_xor(s, 4); s += __shfl_xor(s, 8);
    const float mean = s * (1.0f / 256.0f); float q2 = 0.f;
#pragma unroll
    for (int j = 0; j < 16; ++j) { const float d = acc[j] - mean; q2 += d * d; }
    q2 += __shfl_xor(q2, 1); q2 += __shfl_xor(q2, 2); q2 += __shfl_xor(q2, 4); q2 += __shfl_xor(q2, 8);
    const float rstd = 1.0f / sqrtf(q2 * (1.0f / 256.0f) + EPS);
    bf16_t* dst = P + (size_t)(seq_row0 + n0 + orow) * DIN + C_GR + hh * DV + e0;
#pragma unroll
    for (int j = 0; j < 16; ++j) dst[j] = (bf16_t)f2bf(bf2f(dst[j]) * ((acc[j] - mean) * rstd));
}

__device__ __forceinline__ void b_combine(int tid, int vb, float* xres, float* cres, const bf16_t* Y, const unsigned* base, const int* tok_e, const int* tok_p, const float* tok_w,
                                                  const float* mod_l, int with_ctx, int last, const float* gnext, const float* mod_next, bf16_t* h, const float* g_final) {
    const int lane = tid & 63, R = vb * 8 + (tid >> 6); if (R >= MT) return;
    const RowInfo ri = rinfo(R); if (ri.is_ctx && !with_ctx) return;
    float* xr = ri.is_ctx ? cres + (size_t)ri.nat * D : xres + (size_t)ri.nat * D;
    const unsigned sa = base[tok_e[2 * R]] + (unsigned)tok_p[2 * R], sb = base[tok_e[2 * R + 1]] + (unsigned)tok_p[2 * R + 1];
    const float wa = tok_w[2 * R], wb = tok_w[2 * R + 1];
    const float* gt2 = mod_l + ri.mj * 6144 + 5 * 1024;
    f32x4 v[4]; float ss = 0.f;
#pragma unroll
    for (int j = 0; j < 4; ++j) {
        const int c = 4 * lane + 256 * j;
        const u32x2 ya = *(const u32x2*)(Y + (size_t)sa * D + c), yb = *(const u32x2*)(Y + (size_t)sb * D + c);
        f32x4 y; y.x = wa * bf2f((bf16_t)(ya.x & 0xffffu)) + wb * bf2f((bf16_t)(yb.x & 0xffffu)); y.y = wa * bf2f((bf16_t)(ya.x >> 16)) + wb * bf2f((bf16_t)(yb.x >> 16));
        y.z = wa * bf2f((bf16_t)(ya.y & 0xffffu)) + wb * bf2f((bf16_t)(yb.y & 0xffffu)); y.w = wa * bf2f((bf16_t)(ya.y >> 16)) + wb * bf2f((bf16_t)(yb.y >> 16));
        v[j] = *(const f32x4*)(xr + c) + *(const f32x4*)(gt2 + c) * y;
        ss += (v[j].x * v[j].x + v[j].y * v[j].y) + (v[j].z * v[j].z + v[j].w * v[j].w);
    }
    const float rstd = 1.0f / sqrtf(wave_sum(ss) * (1.0f / 1024.0f) + EPS);
    if (last) {
#pragma unroll
        for (int j = 0; j < 4; ++j) { const int c = 4 * lane + 256 * j; *(f32x4*)(xr + c) = v[j] * rstd * *(const f32x4*)(g_final + c); }
    } else {
        const float* sc = mod_next + ri.mj * 6144 + 1024; const float* sh = mod_next + ri.mj * 6144;
        f32x4 o[4];
#pragma unroll
        for (int j = 0; j < 4; ++j) { const int c = 4 * lane + 256 * j; *(f32x4*)(xr + c) = v[j];
            o[j] = (v[j] * rstd * *(const f32x4*)(gnext + c)) * (1.0f + *(const f32x4*)(sc + c)) + *(const f32x4*)(sh + c); }
        store_row_bf16(h + (size_t)R * D, lane, o);
    }
}
}
namespace nv {
template <class E> struct FDense {
    const bf16_t* A; int lda; const float* B; int ldb_, K_; E e;
    __device__ __forceinline__ int K() const { return K_; }
    __device__ __forceinline__ int ldb() const { return ldb_; }
    __device__ __forceinline__ bool tile_active(int) const { return true; }
    __device__ __forceinline__ const float* b_ptr(int) const { return B; }
    __device__ __forceinline__ const bf16_t* a_row(int r) const { return A + (size_t)r * lda; }
    __device__ __forceinline__ void epi(int r, int c, f32x4 v) const { e(r, c, v); }
};
struct MoeCtx { const unsigned* cnt; const unsigned* base; const int* list; };
__device__ __forceinline__ int moe_expert_of(const unsigned* base, unsigned slot) { int e = 0;
#pragma unroll 1
    for (int i = 1; i < NEXP; ++i) if (base[i] <= slot) e = i; return e; }
struct FMoe1 {
    MoeCtx m; const bf16_t* h2; const float* W; float* G1; bf16_t* Hout; int second;
    __device__ __forceinline__ int K() const { return D; }
    __device__ __forceinline__ int ldb() const { return EFF; }
    __device__ __forceinline__ bool tile_active(int row0) const { return (unsigned)row0 < m.base[NEXP]; }
    __device__ __forceinline__ const float* b_ptr(int row0) const { return W + (size_t)moe_expert_of(m.base, (unsigned)row0) * D * EFF; }
    __device__ __forceinline__ const bf16_t* a_row(int r) const { const int e = moe_expert_of(m.base, (unsigned)r); const unsigned pos = (unsigned)r - m.base[e];
        const int tok = pos < m.cnt[e] ? m.list[(size_t)e * MT + pos] : 0; return h2 + (size_t)tok * D; }
    __device__ __forceinline__ void epi(int r, int c, f32x4 v) const {
        if (!second) *(f32x4*)(G1 + (size_t)r * EFF + c) = v;
        else { const f32x4 a = *(const f32x4*)(G1 + (size_t)r * EFF + c); st4bf(Hout + (size_t)r * EFF + c, (f32x4){siluf_(a.x) * v.x, siluf_(a.y) * v.y, siluf_(a.z) * v.z, siluf_(a.w) * v.w}); }
    }
};
struct FMoe2 {
    MoeCtx m; const bf16_t* Hin; const float* W; bf16_t* Y;
    __device__ __forceinline__ int K() const { return EFF; }
    __device__ __forceinline__ int ldb() const { return D; }
    __device__ __forceinline__ bool tile_active(int row0) const { return (unsigned)row0 < m.base[NEXP]; }
    __device__ __forceinline__ const float* b_ptr(int row0) const { return W + (size_t)moe_expert_of(m.base, (unsigned)row0) * EFF * D; }
    __device__ __forceinline__ const bf16_t* a_row(int r) const { return Hin + (size_t)r * EFF; }
    __device__ __forceinline__ void epi(int r, int c, f32x4 v) const { st4bf(Y + (size_t)r * D + c, v); }
};
}

struct Ptrs {
    const float *x, *c, *ctx, *c_ctx, *w_ada, *b_ada, *g_mix, *g_ffn, *w_in, *w_s, *b_s, *g_sgu, *decay, *w_pa, *w_pb, *w_out, *w_group, *b_group, *w_er, *b_er, *w1, *w3, *w2, *g_final;
    float* out; unsigned char* ws;
    unsigned* ctl; float* mod; float* cres; float* rot; bf16_t* h; bf16_t* P; bf16_t* KV;
    int *tok_e, *tok_p; float* tok_w; int* list;
};
__host__ __device__ static inline Ptrs make_ptrs(void* const* d_in, void* d_out, void* d_ws) {
    Ptrs p{}; const float* const* in = (const float* const*)d_in;
    p.x = in[0]; p.c = in[1]; p.ctx = in[2]; p.c_ctx = in[3]; p.w_ada = in[4]; p.b_ada = in[5]; p.g_mix = in[6]; p.g_ffn = in[7]; p.w_in = in[8]; p.w_s = in[9]; p.b_s = in[10]; p.g_sgu = in[11];
    p.decay = in[12]; p.w_pa = in[13]; p.w_pb = in[14]; p.w_out = in[15]; p.w_group = in[16]; p.b_group = in[17]; p.w_er = in[18]; p.b_er = in[19]; p.w1 = in[20]; p.w3 = in[21]; p.w2 = in[22]; p.g_final = in[23];
    p.out = (float*)d_out; p.ws = (unsigned char*)d_ws;
    p.ctl = (unsigned*)(p.ws + WS_CTL); p.mod = (float*)(p.ws + WS_MOD); p.cres = (float*)(p.ws + WS_CTXRES); p.rot = (float*)(p.ws + WS_ROT);
    p.h = (bf16_t*)(p.ws + WS_H); p.P = (bf16_t*)(p.ws + WS_P); p.KV = (bf16_t*)(p.ws + WS_KV);
    p.tok_e = (int*)(p.ws + WS_TAB + TAB_TOKE); p.tok_p = (int*)(p.ws + WS_TAB + TAB_TOKP); p.tok_w = (float*)(p.ws + WS_TAB + TAB_TOKW); p.list = (int*)(p.ws + WS_TAB + TAB_LIST);
    return p;
}

#define GAS __attribute__((address_space(1)))
#define LAS __attribute__((address_space(3)))
constexpr int NWAVES = 8;
constexpr int LDS_BYTES = 155648;
constexpr int LDSCTL_OFF = 154624;
constexpr int LDS_BASE_OFF = LDSCTL_OFF;
constexpr int LDS_MISC_OFF = LDSCTL_OFF + 512;

#define XB_TMO      128
#define XB_XCNT(j)  (256  + 64 * (j))
#define XB_XSUB(j)  (1280 + 64 * (j))
#define XB_XGEN(j)  (2304 + 64 * (j))
#define XB_TOP      3328
#define XB_TOPGEN   3392
#define XCD_BAR_WORDS 3456
#define XB_SPIN_CAP (1u << 24)
__device__ __forceinline__ unsigned xb_ld(unsigned* p)              { return __hip_atomic_load(p, __ATOMIC_RELAXED, __HIP_MEMORY_SCOPE_AGENT); }
__device__ __forceinline__ unsigned xb_add(unsigned* p, unsigned v) { return __hip_atomic_fetch_add(p, v, __ATOMIC_RELAXED, __HIP_MEMORY_SCOPE_AGENT); }
__device__ __forceinline__ unsigned xb_xcc_id() { return (unsigned)__builtin_amdgcn_s_getreg((3 << 11) | 20) & 0xFu; }
#define XB_SPIN(cond, bar) do { unsigned _sp = 0; while (cond) { __builtin_amdgcn_s_sleep(1); \
    if ((++_sp & 255u) == 0u) { if (xb_ld(&(bar)[XB_TMO])) break; if (_sp > XB_SPIN_CAP) { atomicAdd(&(bar)[XB_TMO], 1u); break; } } } } while (0)
struct XcdBarrier { unsigned* bar; unsigned x; volatile LAS unsigned* st; };
__device__ __forceinline__ XcdBarrier xcd_barrier_post(unsigned* bar, volatile LAS unsigned* st) {
    XcdBarrier b; b.bar = bar; b.x = xb_xcc_id(); b.st = st;
    if (threadIdx.x == 0) (void)xb_add(&bar[XB_XCNT(b.x)], 1u);
    return b;
}
__device__ __forceinline__ void xcd_barrier_complete(unsigned* bar, unsigned x, unsigned& nloc, unsigned& nx) {
    const unsigned G = gridDim.x * gridDim.y * gridDim.z;
    unsigned sum, cnt, mine, sp = 0u;
    for (;;) {
        sum = 0u; cnt = 0u; mine = 0u;
#pragma unroll
        for (unsigned j = 0; j < 16; ++j) { const unsigned c = xb_ld(&bar[XB_XCNT(j)]); sum += c; cnt += (c > 0u) ? 1u : 0u; mine = (j == x) ? c : mine; }
        if (sum == G) break;
        __builtin_amdgcn_s_sleep(1);
        if ((++sp & 255u) == 0u) { if (xb_ld(&bar[XB_TMO])) break; if (sp > XB_SPIN_CAP) { atomicAdd(&bar[XB_TMO], 1u); break; } }
    }
    nloc = mine > 0u ? mine : 1u; nx = cnt > 0u ? cnt : 1u;
}
__device__ __forceinline__ void xcd_barrier(const XcdBarrier& b) {
    asm volatile("s_waitcnt vmcnt(0)" ::: "memory");
    __syncthreads();
    if (threadIdx.x == 0) {
        unsigned* bar = b.bar;
        __builtin_amdgcn_s_waitcnt(0);
        unsigned nloc = b.st[0], nx = b.st[1];
        if (nloc == 0u) { xcd_barrier_complete(bar, b.x, nloc, nx); b.st[0] = nloc; b.st[1] = nx; }
        const unsigned old = xb_add(&bar[XB_XSUB(b.x)], 1u);
        const unsigned gen = old / nloc;
        if (old + 1u == (gen + 1u) * nloc) {
            __builtin_amdgcn_fence(__ATOMIC_RELEASE, "agent");
            asm volatile("s_waitcnt vmcnt(0)" ::: "memory");
            const unsigned og = xb_add(&bar[XB_TOP], 1u);
            const unsigned tg = og / nx;
            if (og + 1u == (tg + 1u) * nx) xb_add(&bar[XB_TOPGEN], 1u);
            else XB_SPIN(xb_ld(&bar[XB_TOPGEN]) == tg, bar);
            __builtin_amdgcn_fence(__ATOMIC_ACQUIRE, "agent");
            xb_add(&bar[XB_XGEN(b.x)], 1u);
            asm volatile("s_waitcnt vmcnt(0)" ::: "memory");
        } else {
            XB_SPIN(xb_ld(&bar[XB_XGEN(b.x)]) == gen, bar);
            __builtin_amdgcn_fence(__ATOMIC_ACQUIRE, "agent");
            asm volatile("s_waitcnt vmcnt(0)" ::: "memory");
        }
    }
    __syncthreads();
}
__device__ __forceinline__ int router_perm_k(int idx) { return 4 * (idx & 63) + ((idx >> 6) & 3) + 256 * (idx >> 8); }
__device__ __forceinline__ void norm2_phase(int tid, char* lds, int bid, int G, const float* xs, const float* cs, const float* gvec, const float* mod_l, bf16_t* h,
                                            const float* w_group, const float* b_group, const float* w_er, const float* b_er,
                                            unsigned* cnt, int* tok_e, int* tok_p, float* tok_w, int* list, int with_ctx) {
    f32x4* Wg4 = (f32x4*)lds; f32x4* We4 = (f32x4*)(lds + 16384);
    __syncthreads();
    for (int idx = tid; idx < 1024; idx += 512) Wg4[idx] = *(const f32x4*)(w_group + (size_t)router_perm_k(idx) * 4);
    for (int i = tid; i < 8192; i += 512) { const int idx = i >> 3, c = i & 7, g = c >> 1, hf = c & 1;
        We4[(g * 2 + hf) * 1024 + idx] = *(const f32x4*)(w_er + (size_t)router_perm_k(idx) * 32 + c * 4); }
    __syncthreads();
    const int lane = tid & 63, wv = tid >> 6;
    const f32x4 bg = *(const f32x4*)b_group;
    for (int R = bid * 8 + wv; R < MT; R += G * 8) {
        const RowInfo ri = rinfo(R); if (ri.is_ctx && !with_ctx) continue;
        const float* src = ri.is_ctx ? cs + (size_t)ri.nat * D : xs + (size_t)ri.nat * D;
        f32x4 v[4]; nv::norm_mod_row(src, gvec, mod_l + ri.mj * 6144 + 4 * 1024, mod_l + ri.mj * 6144 + 3 * 1024, lane, v);
        nv::store_row_bf16(h + (size_t)R * D, lane, v);
        f32x4 gl = (f32x4){0.f, 0.f, 0.f, 0.f};
#pragma unroll
        for (int j = 0; j < 4; ++j)
#pragma unroll
            for (int e = 0; e < 4; ++e) gl += Wg4[(j * 4 + e) * 64 + lane] * v[j][e];
        gl.x = wave_sum(gl.x) + bg.x; gl.y = wave_sum(gl.y) + bg.y; gl.z = wave_sum(gl.z) + bg.z; gl.w = wave_sum(gl.w) + bg.w;
        int gs = 0; float gt = gl.x;
        if (gl.y > gt) { gt = gl.y; gs = 1; } if (gl.z > gt) { gt = gl.z; gs = 2; } if (gl.w > gt) { gt = gl.w; gs = 3; }
        const float pg = 1.0f / (expf(gl.x - gt) + expf(gl.y - gt) + expf(gl.z - gt) + expf(gl.w - gt));
        gs = __builtin_amdgcn_readfirstlane(gs);
        f32x4 ea = (f32x4){0.f, 0.f, 0.f, 0.f}, eb = ea;
        const f32x4* Wa = We4 + (gs * 2) * 1024; const f32x4* Wb = Wa + 1024;
#pragma unroll
        for (int j = 0; j < 4; ++j)
#pragma unroll
            for (int e = 0; e < 4; ++e) { ea += Wa[(j * 4 + e) * 64 + lane] * v[j][e]; eb += Wb[(j * 4 + e) * 64 + lane] * v[j][e]; }
        const f32x4 be0 = *(const f32x4*)(b_er + gs * 8), be1 = *(const f32x4*)(b_er + gs * 8 + 4);
        float eg[8];
        eg[0] = wave_sum(ea.x) + be0.x; eg[1] = wave_sum(ea.y) + be0.y; eg[2] = wave_sum(ea.z) + be0.z; eg[3] = wave_sum(ea.w) + be0.w;
        eg[4] = wave_sum(eb.x) + be1.x; eg[5] = wave_sum(eb.y) + be1.y; eg[6] = wave_sum(eb.z) + be1.z; eg[7] = wave_sum(eb.w) + be1.w;
        int i0 = 0; float e0 = eg[0];
#pragma unroll
        for (int j = 1; j < 8; ++j) if (eg[j] > e0) { e0 = eg[j]; i0 = j; }
        int i1 = -1; float e1 = -3.0e38f;
#pragma unroll
        for (int j = 0; j < 8; ++j) if (j != i0 && eg[j] > e1) { e1 = eg[j]; i1 = j; }
        const float x1 = expf(e1 - e0), w0 = pg / (1.0f + x1), w1 = pg * x1 / (1.0f + x1);
        if (lane == 0) {
            const int ex = gs * 8 + i0, ey = gs * 8 + i1;
            const int pa = (int)atomicAdd(cnt + ex, 1u), pb = (int)atomicAdd(cnt + ey, 1u);
            list[(size_t)ex * MT + pa] = R; list[(size_t)ey * MT + pb] = R;
            tok_e[2 * R] = ex; tok_e[2 * R + 1] = ey; tok_p[2 * R] = pa; tok_p[2 * R + 1] = pb; tok_w[2 * R] = w0; tok_w[2 * R + 1] = w1;
        }
    }
}
namespace pg8 {
#define PG8_LAS __attribute__((address_space(3)))
constexpr int BM = 256, BK = 64, HALF = 128, HTB = HALF * BK * 2, STAGE_BYTES = 8 * HTB, NXCD = 8, WGM = 8;
__host__ __device__ __forceinline__ int lds_byte(int r, int c) { const int st = (r >> 4) * 2 + (c >> 5), rr = r & 15, cc = c & 31, ob = rr * 64 + cc * 2; return st * 1024 + (ob ^ (((ob >> 9) & 1) << 5)); }
__host__ __device__ __forceinline__ void stage_rc(int b, int& R, int& C) { const int st = b / 1024, sb = b % 1024, swz = sb ^ (((sb >> 9) & 1) << 5); R = (st >> 1) * 16 + swz / 64; C = (st & 1) * 32 + (swz % 64) / 2; }
struct Unit { int pm, pn, aux; };
struct TileOrder {
    int nM, nN, nwg, G, c;
    __device__ __forceinline__ void init(int nM_, int nN_, int G_, int c_) { nM = nM_; nN = nN_; nwg = nM * nN; G = G_; c = c_; }
    __device__ __forceinline__ bool tile(int i, int& pm, int& pn) const {
        const long L = (long)i * G + c; if (L >= nwg) return false;
        int wgid = (int)L; { const int q = nwg / NXCD, r = nwg % NXCD, xcd = wgid % NXCD, off = wgid / NXCD; wgid = (xcd < r ? xcd * (q + 1) : r * (q + 1) + (xcd - r) * q) + off; }
        const int nig = WGM * nN, gid = wgid / nig, fm = gid * WGM, gsz = (nM - fm) < WGM ? (nM - fm) : WGM;
        pm = fm + ((wgid % nig) % gsz); pn = (wgid % nig) / gsz; return true;
    }
};

template <class Epi, class Sched, bool ALIGN_EPI>
__device__ __forceinline__ void gemm_phase(int tid, PG8_LAS unsigned char* lds, const Sched& S, const Epi& E, const int K) {
    const int wid = __builtin_amdgcn_readfirstlane(tid >> 6), lane = tid & 63, wr = wid >> 2, wc = wid & 3, fr = lane & 15, fq = lane >> 4;
    const int nt = K / BK;
    int RA[2], CA[2]; unsigned voffB[2];
#pragma unroll
    for (int i = 0; i < 2; ++i) { stage_rc(tid * 16 + i * 8192, RA[i], CA[i]); voffB[i] = (unsigned)(RA[i] * K + CA[i]) * 2u; }
    const size_t kstep = (size_t)(BK * 2);
    const size_t hstepB = (size_t)HALF * K * 2;
    const unsigned ldsw = (unsigned)wid * 1024u;
    const int aoff = lds_byte(wr * 64 + fr, fq * 8), boff = lds_byte(wc * 32 + fr, fq * 8);
#define PG8_SA(b, h) (((b) * 2 + (h)) * HTB)
#define PG8_SB(b, h) ((4 + (b) * 2 + (h)) * HTB)
#define PG8_STAGE(bufoff, gbase, voff) do { _Pragma("unroll") for (int _i = 0; _i < 2; ++_i) \
        __builtin_amdgcn_global_load_lds((const unsigned*)((const char*)(gbase) + (voff)[_i]), (PG8_LAS unsigned*)(lds + (bufoff) + ldsw + _i * 8192), 16, 0, 0); } while (0)
#define PG8_LDA(dst, b, h) do { _Pragma("unroll") for (int m = 0; m < 4; ++m) _Pragma("unroll") for (int k = 0; k < 2; ++k) dst[m][k] = *(const PG8_LAS bf16x8*)(lds + PG8_SA(b, h) + aoff + m * 2048 + k * 1024); } while (0)
#define PG8_LDB(dst, b, h) do { _Pragma("unroll") for (int n = 0; n < 2; ++n) _Pragma("unroll") for (int k = 0; k < 2; ++k) dst[n][k] = *(const PG8_LAS bf16x8*)(lds + PG8_SB(b, h) + boff + n * 2048 + k * 1024); } while (0)
#define PG8_MMA(ai, bj, At, Bt) do { __builtin_amdgcn_s_setprio(1); _Pragma("unroll") for (int m = 0; m < 4; ++m) _Pragma("unroll") for (int n = 0; n < 2; ++n) _Pragma("unroll") for (int k = 0; k < 2; ++k) \
        acc[ai][bj][m][n] = __builtin_amdgcn_mfma_f32_16x16x32_bf16(Bt[n][k], At[m][k], acc[ai][bj][m][n], 0, 0, 0); __builtin_amdgcn_s_setprio(0); } while (0)
#define PG8_WAIT_V(n) asm volatile("s_waitcnt vmcnt(" #n ")" ::: "memory")
#define PG8_WAIT_L(n) asm volatile("s_waitcnt lgkmcnt(" #n ")" ::: "memory")
#define PG8_BAR __builtin_amdgcn_s_barrier()
#define PG8_SCHED __builtin_amdgcn_sched_barrier(0)
#define PG8_AOFFS(dst, u) do { _Pragma("unroll") for (int _h = 0; _h < 2; ++_h) _Pragma("unroll") for (int _i = 0; _i < 2; ++_i) dst[_h][_i] = S.a_rowoff(u, _h * HALF + RA[_i]) + (unsigned)CA[_i] * 2u; } while (0)
    Unit cur, nxt; int ui = 0;
    if (!S.next(0, cur)) return;
    f32x4 acc[2][2][4][2];
#pragma unroll
    for (int a = 0; a < 2; ++a)
#pragma unroll
        for (int b = 0; b < 2; ++b)
#pragma unroll
            for (int m = 0; m < 4; ++m)
#pragma unroll
                for (int n = 0; n < 2; ++n) acc[a][b][m][n] = (f32x4){0.f, 0.f, 0.f, 0.f};
    bf16x8 At[4][2], B0[2][2], B1[2][2];
    const char* cA = S.a_base(cur); const char* cB = S.b_base(cur);
    unsigned vc[2][2], vn[2][2];
    PG8_AOFFS(vc, cur);
    PG8_STAGE(PG8_SB(0, 0), cB, voffB); PG8_STAGE(PG8_SB(0, 1), cB + hstepB, voffB); PG8_STAGE(PG8_SA(0, 0), cA, vc[0]); PG8_STAGE(PG8_SA(0, 1), cA, vc[1]);
    if (wr == 1) PG8_BAR;
    PG8_WAIT_V(2); PG8_BAR;
    PG8_STAGE(PG8_SB(1, 0), cB + kstep, voffB); PG8_STAGE(PG8_SA(1, 0), cA + kstep, vc[0]); PG8_STAGE(PG8_SB(1, 1), cB + hstepB + kstep, voffB);
    PG8_WAIT_V(6); PG8_BAR;
    for (;;) {
        const bool has_next = S.next(ui + 1, nxt);
        const char* nA = has_next ? S.a_base(nxt) : cA; const char* nB = has_next ? S.b_base(nxt) : cB;
        if (has_next) { PG8_AOFFS(vn, nxt); } else {
#pragma unroll
            for (int _h = 0; _h < 2; ++_h)
#pragma unroll
                for (int _i = 0; _i < 2; ++_i) vn[_h][_i] = vc[_h][_i]; }
        for (int t = 0; t < nt; t += 2) {
            const bool last = (t == nt - 2);
            const char* a1 = cA + (size_t)(t + 1) * kstep;
            const char* a2 = last ? nA : cA + (size_t)(t + 2) * kstep; const char* b2 = last ? nB : cB + (size_t)(t + 2) * kstep;
            const char* a3 = a2 + kstep; const char* b3 = b2 + kstep;
            unsigned v2[2][2];
#pragma unroll
            for (int _h = 0; _h < 2; ++_h)
#pragma unroll
                for (int _i = 0; _i < 2; ++_i) v2[_h][_i] = last ? vn[_h][_i] : vc[_h][_i];
            PG8_LDB(B0, 0, 0); PG8_LDB(B1, 0, 1); PG8_SCHED; PG8_LDA(At, 0, 0); PG8_STAGE(PG8_SA(1, 1), a1, vc[1]);
            PG8_WAIT_V(8); PG8_WAIT_L(0); PG8_BAR; PG8_MMA(0, 0, At, B0); PG8_MMA(0, 1, At, B1); PG8_BAR; PG8_SCHED;
            PG8_LDA(At, 0, 1); PG8_STAGE(PG8_SB(0, 0), b2, voffB); PG8_STAGE(PG8_SB(0, 1), b2 + hstepB, voffB); PG8_STAGE(PG8_SA(0, 0), a2, v2[0]);
            PG8_WAIT_V(8); PG8_WAIT_L(0); PG8_BAR; PG8_MMA(1, 0, At, B0); PG8_MMA(1, 1, At, B1); PG8_BAR; PG8_SCHED;
            PG8_LDB(B0, 1, 0); PG8_LDB(B1, 1, 1); PG8_SCHED; PG8_LDA(At, 1, 0); PG8_STAGE(PG8_SA(0, 1), a2, v2[1]);
            PG8_WAIT_V(8); PG8_WAIT_L(0); PG8_BAR; PG8_MMA(0, 0, At, B0); PG8_MMA(0, 1, At, B1); PG8_BAR; PG8_SCHED;
            PG8_LDA(At, 1, 1); PG8_STAGE(PG8_SB(1, 0), b3, voffB); PG8_STAGE(PG8_SB(1, 1), b3 + hstepB, voffB); PG8_STAGE(PG8_SA(1, 0), a3, v2[0]);
            PG8_WAIT_V(8); PG8_WAIT_L(0); PG8_BAR; PG8_MMA(1, 0, At, B0); PG8_MMA(1, 1, At, B1); PG8_BAR; PG8_SCHED;
        }
        if constexpr (ALIGN_EPI) { if (wr == 0) PG8_BAR; }
        E(acc, cur, wr, wc, fr, fq);
        if (!has_next) break;
#pragma unroll
        for (int a = 0; a < 2; ++a)
#pragma unroll
            for (int b = 0; b < 2; ++b)
#pragma unroll
                for (int m = 0; m < 4; ++m)
#pragma unroll
                    for (int n = 0; n < 2; ++n) acc[a][b][m][n] = (f32x4){0.f, 0.f, 0.f, 0.f};
        cur = nxt; cA = nA; cB = nB; ++ui;
#pragma unroll
        for (int _h = 0; _h < 2; ++_h)
#pragma unroll
            for (int _i = 0; _i < 2; ++_i) vc[_h][_i] = vn[_h][_i];
        if constexpr (ALIGN_EPI) { if (wr == 1) PG8_BAR; }
    }
    PG8_WAIT_V(0);
    if constexpr (!ALIGN_EPI) { if (wr == 0) PG8_BAR; }
    PG8_BAR;
#undef PG8_SA
#undef PG8_SB
#undef PG8_STAGE
#undef PG8_LDA
#undef PG8_LDB
#undef PG8_MMA
#undef PG8_WAIT_V
#undef PG8_WAIT_L
#undef PG8_BAR
#undef PG8_SCHED
#undef PG8_AOFFS
}

template <class F> __device__ __forceinline__ void epi_elems(const f32x4 (&acc)[2][2][4][2], int row0, int col0, int wr, int wc, int fr, int fq, const F& f) {
#pragma unroll
    for (int ai = 0; ai < 2; ++ai)
#pragma unroll
        for (int m = 0; m < 4; ++m)
#pragma unroll
            for (int bj = 0; bj < 2; ++bj)
#pragma unroll
                for (int n = 0; n < 2; ++n) f(row0 + ai * HALF + wr * 64 + m * 16 + fr, col0 + bj * HALF + wc * 32 + n * 16 + 4 * fq, acc[ai][bj][m][n]);
}
}
__device__ __forceinline__ void transpose_item(const float* W, int N, bf16_t* WT, int ldt, int drow0, LAS float* scr, int k0, int n0, int lane) {
#pragma unroll 8
    for (int i = 0; i < 32; ++i) { const int kk = 2 * i + (lane >> 5); scr[kk * 33 + (lane & 31)] = W[(size_t)(k0 + kk) * N + n0 + (lane & 31)]; }
    asm volatile("s_waitcnt lgkmcnt(0)" ::: "memory");
    const int c = lane & 7;
#pragma unroll
    for (int j = 0; j < 4; ++j) { const int n = (lane >> 3) + 8 * j; const LAS float* s = scr + (8 * c) * 33 + n;
        u32x4 o; o.x = pk2(s[0 * 33], s[1 * 33]); o.y = pk2(s[2 * 33], s[3 * 33]); o.z = pk2(s[4 * 33], s[5 * 33]); o.w = pk2(s[6 * 33], s[7 * 33]);
        *(u32x4*)(WT + (size_t)(drow0 + n) * ldt + k0 + 8 * c) = o; }
    asm volatile("s_waitcnt lgkmcnt(0)" ::: "memory");
}
constexpr int CONV_IN_ITEMS = 16 * 224, CONV_PROJ_ITEMS = 16 * 32, CONV_MOE_ITEMS = NEXP * 768;
__device__ __forceinline__ bf16_t* win_t(const Ptrs& p, int l) { return (bf16_t*)(p.ws + WS_WIN) + (size_t)l * DIN * D; }
__device__ __forceinline__ bf16_t* wproj_t(const Ptrs& p, int l, int j) { return (bf16_t*)(p.ws + WS_WPROJ) + (size_t)(l * 3 + j) * D * D; }
__device__ __forceinline__ bf16_t* w13_t(const Ptrs& p) { return (bf16_t*)(p.ws + WS_WMOE); }
__device__ __forceinline__ bf16_t* w2_t(const Ptrs& p) { return (bf16_t*)(p.ws + WS_WMOE + 64 * MiB); }
__device__ __forceinline__ bf16_t* ws_b(const Ptrs& p, int l) { return (bf16_t*)(p.ws + WS_WS) + (size_t)l * 8 * 128 * 128; }

__device__ __forceinline__ void conv_moe(int tid, char* lds, const Ptrs& p, int l, int bid, int G) {
    const int lane = tid & 63, wv = tid >> 6; LAS float* scr = (LAS float*)(lds + wv * 16384);
    __syncthreads();
    for (int it = bid * 8 + wv; it < CONV_MOE_ITEMS; it += G * 8) {
        const int e = it / 768, r = it % 768;
        if (r < 512) { const int which = r >> 8, r2 = r & 255, kb = r2 >> 4, nb = r2 & 15, n0 = nb * 32;
            const float* W = (which ? p.w3 : p.w1) + ((size_t)l * NEXP + e) * D * EFF;
            transpose_item(W, EFF, w13_t(p) + (size_t)e * 1024 * 1024, 1024, (n0 >> 7) * 256 + which * 128 + (n0 & 127), scr, kb * 64, n0, lane);
        } else { const int r2 = r - 512, kb = r2 >> 5, nb = r2 & 31;
            transpose_item(p.w2 + ((size_t)l * NEXP + e) * EFF * D, D, w2_t(p) + (size_t)e * 1024 * 512, 512, nb * 32, scr, kb * 64, nb * 32, lane); }
    }
}
__device__ __forceinline__ void fast_prologue(int tid, char* lds, const Ptrs& p, int bid, int G) {
    const int lane = tid & 63, wv = tid >> 6; LAS float* scr = (LAS float*)(lds + wv * 16384);
    __syncthreads();
    const int NIT = DEPTH * CONV_IN_ITEMS + DEPTH * 3 * CONV_PROJ_ITEMS;
    for (int it = bid * 8 + wv; it < NIT; it += G * 8) {
        if (it < DEPTH * CONV_IN_ITEMS) { const int l = it / CONV_IN_ITEMS, r = it % CONV_IN_ITEMS, kb = r / 224, nb = r % 224;
            transpose_item(p.w_in + (size_t)l * D * DIN, DIN, win_t(p, l), D, nb * 32, scr, kb * 64, nb * 32, lane);
        } else { const int r0 = it - DEPTH * CONV_IN_ITEMS, m = r0 / CONV_PROJ_ITEMS, r = r0 % CONV_PROJ_ITEMS, l = m / 3, j = m % 3, kb = r >> 5, nb = r & 31;
            const float* W = (j == 0 ? p.w_pa : j == 1 ? p.w_pb : p.w_out) + (size_t)l * D * D;
            transpose_item(W, D, wproj_t(p, l, j), D, nb * 32, scr, kb * 64, nb * 32, lane); }
    }
    conv_moe(tid, lds, p, 0, bid, G);
    for (int i = bid * 512 + tid; i < DEPTH * 8 * 128 * 128 / 4; i += G * 512) { const f32x4 v = *(const f32x4*)(p.w_s + (size_t)i * 4); u32x2 o; o.x = pk2(v.x, v.y); o.y = pk2(v.z, v.w); *(u32x2*)((bf16_t*)(p.ws + WS_WS) + (size_t)i * 4) = o; }
}

struct SchedIn {
    pg8::TileOrder o1, o2; const char* A; const char* B; int n1, G, c, kv_only;
    __device__ __forceinline__ void init(const bf16_t* h_g, const bf16_t* wt, int G_, int c_, int kv_only_) { A = (const char*)h_g; B = (const char*)wt; G = G_; c = c_; kv_only = kv_only_;
        o1.init(GX / 256, DIN / 256, 1, 0); o2.init(GC / 256, kv_only ? 6 : DIN / 256, 1, 0); n1 = o1.nwg; }
    __device__ __forceinline__ bool next(int i, pg8::Unit& u) const { const int L = i * G + c; u.aux = 0;
        if (L < n1) return o1.tile(L, u.pm, u.pn);
        int pm, pn; if (!o2.tile(L - n1, pm, pn)) return false; u.pm = GX / 256 + pm; u.pn = kv_only ? C_K / 256 + pn : pn; return true; }
    __device__ __forceinline__ const char* a_base(const pg8::Unit& u) const { return A + (size_t)u.pm * 256 * D * 2; }
    __device__ __forceinline__ const char* b_base(const pg8::Unit& u) const { return B + (size_t)u.pn * 256 * D * 2; }
    __device__ __forceinline__ unsigned a_rowoff(const pg8::Unit&, int r) const { return (unsigned)r * (D * 2); }
};
struct EpiInT { EpiIn e; __device__ __forceinline__ void operator()(const f32x4 (&acc)[2][2][4][2], const pg8::Unit& u, int wr, int wc, int fr, int fq) const { pg8::epi_elems(acc, u.pm * 256, u.pn * 256, wr, wc, fr, fq, e); } };

struct SchedMerge {
    pg8::TileOrder o; const char* P; const char* Ba; const char* Bb;
    __device__ __forceinline__ bool next(int i2, pg8::Unit& u) const { u.aux = i2 & 1; return o.tile(i2 >> 1, u.pm, u.pn); }
    __device__ __forceinline__ const char* a_base(const pg8::Unit& u) const { return P + ((size_t)u.pm * 256 * DIN + (u.aux ? C_GR : C_U)) * 2; }
    __device__ __forceinline__ const char* b_base(const pg8::Unit& u) const { return (u.aux ? Bb : Ba) + (size_t)u.pn * 256 * D * 2; }
    __device__ __forceinline__ unsigned a_rowoff(const pg8::Unit&, int r) const { return (unsigned)r * (DIN * 2); }
};
struct EpiMergeT { bf16_t* P;
    __device__ __forceinline__ void operator()(const f32x4 (&acc)[2][2][4][2], const pg8::Unit& u, int wr, int wc, int fr, int fq) const {
        if (u.aux == 0) { EpiMergeA e{P}; pg8::epi_elems(acc, u.pm * 256, u.pn * 256, wr, wc, fr, fq, e); }
        else { EpiMergeB e{P}; pg8::epi_elems(acc, u.pm * 256, u.pn * 256, wr, wc, fr, fq, e); } } };
struct SchedOut {
    pg8::TileOrder o; const char* P; const char* B;
    __device__ __forceinline__ bool next(int i, pg8::Unit& u) const { u.aux = 0; return o.tile(i, u.pm, u.pn); }
    __device__ __forceinline__ const char* a_base(const pg8::Unit& u) const { return P + ((size_t)u.pm * 256 * DIN + C_GA) * 2; }
    __device__ __forceinline__ const char* b_base(const pg8::Unit& u) const { return B + (size_t)u.pn * 256 * D * 2; }
    __device__ __forceinline__ unsigned a_rowoff(const pg8::Unit&, int r) const { return (unsigned)r * (DIN * 2); }
};
struct EpiOutT { EpiOut e; __device__ __forceinline__ void operator()(const f32x4 (&acc)[2][2][4][2], const pg8::Unit& u, int wr, int wc, int fr, int fq) const { pg8::epi_elems(acc, u.pm * 256, u.pn * 256, wr, wc, fr, fq, e); } };

struct SchedMoe1 {
    pg8::TileOrder o; const char* h2; const char* W; const unsigned* cnt; const unsigned* base; const int* list;
    __device__ __forceinline__ bool next(int i, pg8::Unit& u) const { if (!o.tile(i, u.pm, u.pn)) return false; u.aux = nv::moe_expert_of(base, (unsigned)u.pm * 256u); return true; }
    __device__ __forceinline__ const char* a_base(const pg8::Unit&) const { return h2; }
    __device__ __forceinline__ const char* b_base(const pg8::Unit& u) const { return W + ((size_t)u.aux * 1024 + (size_t)u.pn * 256) * D * 2; }
    __device__ __forceinline__ unsigned a_rowoff(const pg8::Unit& u, int r) const { const unsigned pos = (unsigned)u.pm * 256u + (unsigned)r - base[u.aux];
        const int tok = pos < cnt[u.aux] ? list[(size_t)u.aux * MT + pos] : 0; return (unsigned)tok * (D * 2); }
};
struct EpiMoe1T { bf16_t* H;
    __device__ __forceinline__ void operator()(const f32x4 (&acc)[2][2][4][2], const pg8::Unit& u, int wr, int wc, int fr, int fq) const {
#pragma unroll
        for (int ai = 0; ai < 2; ++ai)
#pragma unroll
            for (int m = 0; m < 4; ++m)
#pragma unroll
                for (int n = 0; n < 2; ++n) { const f32x4 a = acc[ai][0][m][n], b = acc[ai][1][m][n];
                    st4bf(H + (size_t)(u.pm * 256 + ai * 128 + wr * 64 + m * 16 + fr) * EFF + u.pn * 128 + wc * 32 + n * 16 + 4 * fq, (f32x4){siluf_(a.x) * b.x, siluf_(a.y) * b.y, siluf_(a.z) * b.z, siluf_(a.w) * b.w}); } } };
struct SchedMoe2 {
    pg8::TileOrder o; const char* H; const char* W; const unsigned* base;
    __device__ __forceinline__ bool next(int i, pg8::Unit& u) const { if (!o.tile(i, u.pm, u.pn)) return false; u.aux = nv::moe_expert_of(base, (unsigned)u.pm * 256u); return true; }
    __device__ __forceinline__ const char* a_base(const pg8::Unit& u) const { return H + (size_t)u.pm * 256 * EFF * 2; }
    __device__ __forceinline__ const char* b_base(const pg8::Unit& u) const { return W + ((size_t)u.aux * 1024 + (size_t)u.pn * 256) * EFF * 2; }
    __device__ __forceinline__ unsigned a_rowoff(const pg8::Unit&, int r) const { return (unsigned)r * (EFF * 2); }
};
struct EpiYStore { bf16_t* Y; __device__ __forceinline__ void operator()(int row, int col0, f32x4 v) const { st4bf(Y + (size_t)row * D + col0, v); } };
struct EpiMoe2T { EpiYStore e; __device__ __forceinline__ void operator()(const f32x4 (&acc)[2][2][4][2], const pg8::Unit& u, int wr, int wc, int fr, int fq) const { pg8::epi_elems(acc, u.pm * 256, u.pn * 256, wr, wc, fr, fq, e); } };

__device__ __forceinline__ void fast_gemm_in(int tid, char* lds, const Ptrs& p, int l, int g, int bid, int G) {
    SchedIn S; S.init(p.h + (size_t)g * GR * D, win_t(p, l), G, bid, l == DEPTH - 1 ? 1 : 0);
    EpiInT E; E.e.P = p.P; E.e.rot = p.rot;
    pg8::gemm_phase<EpiInT, SchedIn, true>(tid, (PG8_LAS unsigned char*)lds, S, E, D);
}
__device__ __forceinline__ void fast_merge(int tid, char* lds, const Ptrs& p, int l, int Mrows, int bid, int G) {
    SchedMerge S; S.o.init(Mrows / 256, D / 256, G, bid); S.P = (const char*)p.P; S.Ba = (const char*)wproj_t(p, l, 0); S.Bb = (const char*)wproj_t(p, l, 1);
    EpiMergeT E; E.P = p.P;
    pg8::gemm_phase<EpiMergeT, SchedMerge, true>(tid, (PG8_LAS unsigned char*)lds, S, E, D);
}
__device__ __forceinline__ void fast_out(int tid, char* lds, const Ptrs& p, int l, int g, int Mrows, int bid, int G) {
    SchedOut S; S.o.init(Mrows / 256, D / 256, G, bid); S.P = (const char*)p.P; S.B = (const char*)wproj_t(p, l, 2);
    EpiOutT E; E.e.xsrc = l == 0 ? p.x : p.out; E.e.csrc = l == 0 ? p.ctx : p.cres; E.e.xdst = p.out; E.e.cdst = p.cres; E.e.mod_l = p.mod + (size_t)l * 9 * 6144; E.e.g = g;
    pg8::gemm_phase<EpiOutT, SchedOut, true>(tid, (PG8_LAS unsigned char*)lds, S, E, D);
}
__device__ __forceinline__ void fast_moe1(int tid, char* lds, const Ptrs& p, const unsigned* cnt, const unsigned* lbase, int bid, int G) {
    SchedMoe1 S; S.o.init((int)(lbase[NEXP] >> 8), 4, G, bid); S.h2 = (const char*)p.h; S.W = (const char*)w13_t(p); S.cnt = cnt; S.base = lbase; S.list = p.list;
    EpiMoe1T E; E.H = (bf16_t*)(p.ws + WS_MOEH);
    pg8::gemm_phase<EpiMoe1T, SchedMoe1, true>(tid, (PG8_LAS unsigned char*)lds, S, E, D);
}
__device__ __forceinline__ void fast_moe2(int tid, char* lds, const Ptrs& p, const unsigned* lbase, int bid, int G) {
    SchedMoe2 S; S.o.init((int)(lbase[NEXP] >> 8), 4, G, bid); S.H = (const char*)(p.ws + WS_MOEH); S.W = (const char*)w2_t(p); S.base = lbase;
    EpiMoe2T E; E.e.Y = (bf16_t*)(p.ws + WS_MOEY);
    pg8::gemm_phase<EpiMoe2T, SchedMoe2, true>(tid, (PG8_LAS unsigned char*)lds, S, E, EFF);
}
constexpr int PH_PER_LAYER = 16, N_PRO = 2, N_PHASES = N_PRO + DEPTH * PH_PER_LAYER;
struct Args { const float* in[24]; float* out; unsigned char* ws; int ph_lo, ph_hi; };

#ifndef FAST_GEMM_IN
#define FAST_GEMM_IN 0
#endif
#ifndef FAST_MERGE
#define FAST_MERGE 0
#endif
#ifndef FAST_OUT
#define FAST_OUT 0
#endif
#ifndef FAST_MOE
#define FAST_MOE 0
#endif
#ifndef FAST_SGU
#define FAST_SGU 0
#endif
#ifndef FAST_RET
#define FAST_RET 0
#endif

#define TID_HERE const int tid = ({ int t_ = threadIdx.x; asm volatile("" : "+v"(t_)); t_; })
__global__ void __launch_bounds__(NWAVES * 64, 2) mega(Args args) {
    extern __shared__ __attribute__((aligned(16))) unsigned char lds_raw[];
    char* lds = (char*)lds_raw;
    const int G = gridDim.x, bid = blockIdx.x;
    const Ptrs p = make_ptrs((void* const*)args.in, args.out, args.ws);
    for (int u = threadIdx.x; u < (LDS_BYTES - LDSCTL_OFF) / 4; u += NWAVES * 64) ((LAS unsigned*)(lds_raw + LDSCTL_OFF))[u] = 0u;
    __syncthreads();
    unsigned* lbase = (unsigned*)(lds + LDS_BASE_OFF);
    XcdBarrier bar = xcd_barrier_post(p.ctl + CW_BAR, (volatile LAS unsigned*)(lds_raw + LDS_MISC_OFF) + 8);

    for (int ph = args.ph_lo; ph < args.ph_hi; ++ph) {
        if (ph == 0) {
            TID_HERE;
            for (int vb = bid; vb < 192; vb += G) nv::b_mod(tid, lds, vb, p.c, p.c_ctx, p.w_ada, p.b_ada, p.mod);
            for (int vb = bid; vb < SEQ * 64 / 512; vb += G) nv::b_rot(tid, vb, p.rot);
            fast_prologue(tid, lds, p, bid, G);
        } else if (ph == 1) {
            TID_HERE;
            for (int vb = bid; vb < MT / 8; vb += G) nv::b_norm1(tid, vb, p.x, p.ctx, p.g_mix, p.mod, p.h);
        } else {
            const int q = ph - N_PRO, l = q / PH_PER_LAYER, r = q % PH_PER_LAYER;
            const float* mod_l = p.mod + (size_t)l * 9 * 6144;
            if (r < 12) {
                const int g = r / 6, st = r % 6;
                const int Mrows = l == 0 ? GR : GX;
                if (st == 0) {
                    TID_HERE;
#if FAST_GEMM_IN
                    fast_gemm_in(tid, lds, p, l, g, bid, G);
#else
                    nv::FDense<EpiIn> f{}; f.A = p.h + (size_t)g * GR * D; f.lda = D; f.B = p.w_in + (size_t)l * D * DIN; f.ldb_ = DIN; f.K_ = D; f.e.P = p.P; f.e.rot = p.rot;
                    for (int vb = bid; vb < (DIN / 64) * (GR / 128); vb += G) nv::b_gemm(tid, lds, vb % (DIN / 64), vb / (DIN / 64), f);
#endif
                } else if (st == 1) {
                    TID_HERE;
#if FAST_SGU
                    fast_sgu(lds, p, l);
#else
                    const int chunks = GB * 32 + (l == 0 ? GB * 2 : 0);
                    for (int vb = bid; vb < chunks * 8; vb += G) nv::b_sgu(tid, lds, vb >> 3, vb & 7, p.P, p.w_s + (size_t)l * 8 * 128 * 128, p.b_s + l * 8 * 128, p.g_sgu + l * 1024);
#endif
#if FAST_RET
                    fast_ret_kv(lds, p, l);
#endif
                } else if (st == 2) {
                    TID_HERE; (void)tid;
#if FAST_RET
                    fast_ret_scan(lds, p, l);
#endif
#if FAST_MOE
                    if (l == 1 && g == 0) conv_moe(tid, lds, p, 1, bid, G);
#endif
                } else if (st == 3) {
                    TID_HERE;
#if FAST_RET
                    fast_ret_out(lds, p, l);
#else
                    for (int vb = bid; vb < (SEQ / 32) * NHEAD * GB; vb += G) nv::b_ret(tid, lds, vb % (SEQ / 32), (vb / (SEQ / 32)) % NHEAD, vb / ((SEQ / 32) * NHEAD), p.P, p.decay + l * 8, 0);
                    if (l == 0) for (int vb = bid; vb < (CTXL / 32) * NHEAD * GB; vb += G) nv::b_ret(tid, lds, vb % (CTXL / 32), (vb / (CTXL / 32)) % NHEAD, vb / ((CTXL / 32) * NHEAD), p.P, p.decay + l * 8, 1);
#endif
                } else if (st == 4) {
                    TID_HERE;
#if FAST_MERGE
                    fast_merge(tid, lds, p, l, Mrows, bid, G);
#else
                    nv::FDense<EpiMergeA> fa{}; fa.A = p.P + C_U; fa.lda = DIN; fa.B = p.w_pa + (size_t)l * D * D; fa.ldb_ = D; fa.K_ = D; fa.e.P = p.P;
                    nv::FDense<EpiMergeB> fb{}; fb.A = p.P + C_GR; fb.lda = DIN; fb.B = p.w_pb + (size_t)l * D * D; fb.ldb_ = D; fb.K_ = D; fb.e.P = p.P;
                    for (int vb = bid; vb < (D / 64) * (Mrows / 128); vb += G) { nv::b_gemm(tid, lds, vb % (D / 64), vb / (D / 64), fa); nv::b_gemm(tid, lds, vb % (D / 64), vb / (D / 64), fb); }
#endif
                } else {
                    TID_HERE;
#if FAST_OUT
                    fast_out(tid, lds, p, l, g, Mrows, bid, G);
#else
                    nv::FDense<EpiOut> f{}; f.A = p.P + C_GA; f.lda = DIN; f.B = p.w_out + (size_t)l * D * D; f.ldb_ = D; f.K_ = D;
                    f.e.xsrc = l == 0 ? p.x : p.out; f.e.csrc = l == 0 ? p.ctx : p.cres; f.e.xdst = p.out; f.e.cdst = p.cres; f.e.mod_l = mod_l; f.e.g = g;
                    for (int vb = bid; vb < (D / 64) * (Mrows / 128); vb += G) nv::b_gemm(tid, lds, vb % (D / 64), vb / (D / 64), f);
#endif
                }
            } else {
                const int st = r - 12;
                unsigned* cnt = p.ctl + CW_CNT + l * 32;
                bf16_t* Hb = (bf16_t*)(p.ws + WS_MOEH); float* G1 = (float*)(p.ws + WS_MOEY); bf16_t* Y = (bf16_t*)(p.ws + WS_MOEY);
                if (st == 0) {
                    TID_HERE;
                    norm2_phase(tid, lds, bid, G, p.out, p.cres, p.g_ffn + l * D, mod_l, p.h, p.w_group + l * D * 4, p.b_group + l * 4, p.w_er + l * D * 32, p.b_er + l * 32, cnt, p.tok_e, p.tok_p, p.tok_w, p.list, l == 0 ? 1 : 0);
                } else if (st == 1) {
                    TID_HERE;
                    nv::b_offsets(tid, cnt, lbase);
#if FAST_MOE
                    fast_moe1(tid, lds, p, cnt, lbase, bid, G);
#else
                    nv::MoeCtx m{cnt, lbase, p.list};
                    nv::FMoe1 f1{}; f1.m = m; f1.h2 = p.h; f1.W = p.w1 + (size_t)l * NEXP * D * EFF; f1.G1 = G1; f1.Hout = Hb; f1.second = 0;
                    nv::FMoe1 f3 = f1; f3.W = p.w3 + (size_t)l * NEXP * D * EFF; f3.second = 1;
                    for (int vb = bid; vb < (EFF / 64) * (SLOT_CAP / 128); vb += G) { nv::b_gemm(tid, lds, vb % (EFF / 64), vb / (EFF / 64), f1); nv::b_gemm(tid, lds, vb % (EFF / 64), vb / (EFF / 64), f3); }
#endif
                } else if (st == 2) {
                    TID_HERE;
                    nv::b_offsets(tid, cnt, lbase);
#if FAST_MOE
                    fast_moe2(tid, lds, p, lbase, bid, G);
#else
                    nv::MoeCtx m{cnt, lbase, p.list};
                    nv::FMoe2 f2{}; f2.m = m; f2.Hin = Hb; f2.W = p.w2 + (size_t)l * NEXP * EFF * D; f2.Y = Y;
                    for (int vb = bid; vb < (D / 64) * (SLOT_CAP / 128); vb += G) nv::b_gemm(tid, lds, vb % (D / 64), vb / (D / 64), f2);
#endif
                } else {
                    TID_HERE;
                    nv::b_offsets(tid, cnt, lbase);
                    const int last = (l == DEPTH - 1);
                    for (int vb = bid; vb < MT / 8; vb += G)
                        nv::b_combine(tid, vb, p.out, p.cres, Y, lbase, p.tok_e, p.tok_p, p.tok_w, mod_l, l == 0 ? 1 : 0, last, last ? p.g_mix : p.g_mix + (l + 1) * D, last ? p.mod : p.mod + (size_t)(l + 1) * 9 * 6144, p.h, p.g_final);
                }
            }
        }
        if (ph + 1 < args.ph_hi) xcd_barrier(bar);
    }
}

extern "C" void kernel_launch(void* const* d_in, const int* in_sizes, int n_in, void* d_out, int out_size, void* d_ws, size_t ws_size, hipStream_t stream) {
    static int grid = 0;
    if (grid == 0) {
        if (n_in != 24 || out_size != TX * D || ws_size < WS_END) { fprintf(stderr, "kernel_launch: unexpected sizes n_in %d out %d ws %zu\n", n_in, out_size, ws_size); grid = -1; return; }
        int dev = 0, cus = 0, per_cu = 0;
        if (hipGetDevice(&dev) != hipSuccess || hipDeviceGetAttribute(&cus, hipDeviceAttributeMultiprocessorCount, dev) != hipSuccess) { grid = -1; return; }
        if (hipFuncSetAttribute((const void*)mega, hipFuncAttributeMaxDynamicSharedMemorySize, LDS_BYTES) != hipSuccess) { fprintf(stderr, "kernel_launch: hipFuncSetAttribute failed\n"); grid = -1; return; }
        if (hipOccupancyMaxActiveBlocksPerMultiprocessor(&per_cu, (const void*)mega, NWAVES * 64, LDS_BYTES) != hipSuccess || per_cu < 1) fprintf(stderr, "kernel_launch: occupancy query says %d\n", per_cu);
        (void)hipGetLastError();
        grid = cus;
    }
    if (grid < 0) return;
    (void)hipMemsetAsync((char*)d_ws + WS_CTL, 0, CTL_BYTES, stream);
    Args a{};
    for (int i = 0; i < 24; ++i) a.in[i] = (const float*)d_in[i];
    a.out = (float*)d_out; a.ws = (unsigned char*)d_ws;
#ifndef N_LAUNCH_SPLIT
    a.ph_lo = 0; a.ph_hi = N_PHASES;
    hipLaunchKernelGGL(mega, dim3(grid), dim3(NWAVES * 64), LDS_BYTES, stream, a);
#else
    for (int ph = 0; ph < N_PHASES; ++ph) { a.ph_lo = ph; a.ph_hi = ph + 1; hipLaunchKernelGGL(mega, dim3(grid), dim3(NWAVES * 64), LDS_BYTES, stream, a); }
#endif
}
```

```cpp
#define FAST_GEMM_IN 1
#define FAST_MERGE 1
#define FAST_OUT 1
#define FAST_MOE 1
#define FAST_SGU 1
#define FAST_RET 1
#include <hip/hip_runtime.h>
#include <cstdio>
#include <cstdint>
#include <cmath>

typedef unsigned short bf16_t;
typedef float f32x4 __attribute__((ext_vector_type(4)));
typedef float f32x2 __attribute__((ext_vector_type(2)));
typedef unsigned u32x4 __attribute__((ext_vector_type(4)));
typedef unsigned u32x2 __attribute__((ext_vector_type(2)));
typedef short bf16x8 __attribute__((ext_vector_type(8)));

constexpr int D = 1024, NB = 8, SEQ = 4096, CTXL = 256, DEPTH = 2;
constexpr int TX = NB * SEQ, TC = NB * CTXL, MT = TX + TC;
constexpr int DIN = 7168;
constexpr int C_U = 0, C_VA = 1024, C_Q = 2048, C_K = 2560, C_V = 3072, C_GR = 4096, C_GA = 5120, C_GB = 6144;
constexpr int NGRP = 2, GB = NB / NGRP;
constexpr int GX = GB * SEQ, GC = GB * CTXL, GR = GX + GC;
constexpr int NHEAD = 4, DK = 128, DV = 256, CH = 128;
constexpr int NEXP = 32, EFF = 512;
constexpr int SLOT_CAP = 2 * MT + NEXP * 256;
constexpr float EPS = 1e-6f;

constexpr size_t MiB = 1u << 20;
constexpr size_t WS_CTL = 0;
constexpr size_t CTL_BYTES = 1 * MiB;
constexpr size_t WS_MOD = 1 * MiB;
constexpr size_t WS_TAB = 2 * MiB;
constexpr size_t WS_CTXRES = 8 * MiB;
constexpr size_t WS_WIN = 16 * MiB;
constexpr size_t WS_WPROJ = 44 * MiB;
constexpr size_t WS_WS = 56 * MiB;
constexpr size_t WS_ROT = 57 * MiB;
constexpr size_t WS_WMOE = 60 * MiB;
constexpr size_t WS_H = 156 * MiB;
constexpr size_t WS_KV = 224 * MiB;
constexpr size_t WS_P = 292 * MiB;
constexpr size_t WS_END = 530 * MiB;
constexpr size_t P_BYTES = (size_t)GR * DIN * 2;
static_assert(WS_P + P_BYTES <= WS_END, "ws map");
constexpr size_t WS_MOEH = WS_P;
constexpr size_t WS_MOEY = WS_P + 76 * MiB;
static_assert((size_t)SLOT_CAP * EFF * 2 <= 76 * MiB && WS_MOEY + (size_t)SLOT_CAP * D * 2 <= WS_END, "moe map");

constexpr size_t TAB_TOKE = 0;
constexpr size_t TAB_TOKP = TAB_TOKE + (size_t)MT * 8;
constexpr size_t TAB_TOKW = TAB_TOKP + (size_t)MT * 8;
constexpr size_t TAB_LIST = 1 * MiB;
static_assert(TAB_TOKW + (size_t)MT * 8 <= TAB_LIST && TAB_LIST + (size_t)NEXP * MT * 4 <= 6 * MiB, "tab map");
constexpr int CW_CNT = 64;
constexpr int CW_BASE = 256;
constexpr int CW_BAR = 4096;

__device__ __forceinline__ float bf2f(bf16_t v) { return __uint_as_float(((unsigned)v) << 16); }
__device__ __forceinline__ unsigned f2bf(float f) { unsigned u = __float_as_uint(f); return (u + 0x7fffu + ((u >> 16) & 1u)) >> 16; }
__device__ __forceinline__ unsigned pk2(float lo, float hi) { return f2bf(lo) | (f2bf(hi) << 16); }
__device__ __forceinline__ float sigmoidf_(float x) { return 1.0f / (1.0f + __expf(-x)); }
__device__ __forceinline__ float siluf_(float x) { return x / (1.0f + __expf(-x)); }
__device__ __forceinline__ float geluf_(float x) { const float z = 0.7978845608028654f * (x + 0.044715f * x * x * x); return x / (1.0f + __expf(-2.0f * z)); }
__device__ __forceinline__ float wave_sum(float v) {
#pragma unroll
    for (int o = 1; o < 64; o <<= 1) v += __shfl_xor(v, o);
    return v;
}
struct RowInfo { int b, is_ctx, nat, mj; };
__device__ __forceinline__ RowInfo rinfo(int R) {
    RowInfo r; const int g = R / GR, loc = R - g * GR;
    if (loc < GX) { r.b = g * GB + (loc >> 12); r.is_ctx = 0; r.nat = r.b * SEQ + (loc & 4095); r.mj = r.b; }
    else { const int lc = loc - GX; r.b = g * GB + (lc >> 8); r.is_ctx = 1; r.nat = r.b * CTXL + (lc & 255); r.mj = 8; }
    return r;
}
__device__ __forceinline__ void st4bf(bf16_t* p, f32x4 v) { u32x2 w; w.x = pk2(v.x, v.y); w.y = pk2(v.z, v.w); *(u32x2*)p = w; }
__device__ __forceinline__ f32x4 ld4bf(const bf16_t* p) { const u32x2 w = *(const u32x2*)p; return (f32x4){bf2f((bf16_t)(w.x & 0xffffu)), bf2f((bf16_t)(w.x >> 16)), bf2f((bf16_t)(w.y & 0xffffu)), bf2f((bf16_t)(w.y >> 16))}; }

struct EpiIn {
    bf16_t* P; const float* rot;
    __device__ __forceinline__ void operator()(int row, int col0, f32x4 v) const {
        if (col0 < C_Q) { v = (f32x4){geluf_(v.x), geluf_(v.y), geluf_(v.z), geluf_(v.w)}; }
        else if (col0 < C_V) {
            if (col0 >= C_K) v = v * 0.08838834764831845f;
            if (row < GX) {
                const int n = row & (SEQ - 1), i2 = ((col0 - C_Q) & 127) >> 1;
                const f32x4 cs = *(const f32x4*)(rot + ((size_t)n * 64 + i2) * 2);
                v = (f32x4){v.x * cs.x - v.y * cs.y, v.x * cs.y + v.y * cs.x, v.z * cs.z - v.w * cs.w, v.z * cs.w + v.w * cs.z};
            }
        }
        else if (col0 < C_GR) { }
        else if (col0 < C_GA) { v = (f32x4){siluf_(v.x), siluf_(v.y), siluf_(v.z), siluf_(v.w)}; }
        else { v = (f32x4){sigmoidf_(v.x), sigmoidf_(v.y), sigmoidf_(v.z), sigmoidf_(v.w)}; }
        st4bf(P + (size_t)row * DIN + col0, v);
    }
};
struct EpiMergeA {
    bf16_t* P;
    __device__ __forceinline__ void operator()(int row, int col0, f32x4 v) const {
        bf16_t* p = P + (size_t)row * DIN + C_GA + col0; st4bf(p, ld4bf(p) * v);
    }
};
struct EpiMergeB {
    bf16_t* P;
    __device__ __forceinline__ void operator()(int row, int col0, f32x4 v) const {
        bf16_t* p = P + (size_t)row * DIN + C_GA + col0; st4bf(p, ld4bf(p) + ld4bf(P + (size_t)row * DIN + C_GB + col0) * v);
    }
};
struct EpiOut {
    const float* xsrc; const float* csrc; float* xdst; float* cdst; const float* mod_l; int g;
    __device__ __forceinline__ void operator()(int row, int col0, f32x4 v) const {
        const RowInfo ri = rinfo(g * GR + row);
        const size_t off = (size_t)ri.nat * D + col0;
        const f32x4 gt = *(const f32x4*)(mod_l + ri.mj * 6144 + 2 * 1024 + col0);
        const float* xs_ = xsrc; const float* cs_ = csrc; float* xd_ = xdst; float* cd_ = cdst;
        const float* src = ri.is_ctx ? cs_ : xs_; float* dst = ri.is_ctx ? cd_ : xd_;
        *(f32x4*)(dst + off) = *(const f32x4*)(src + off) + gt * v;
    }
};
namespace nv {

__device__ __forceinline__ void b_mod(int tid, char* lds, int vb, const float* c, const float* c_ctx, const float* w_ada, const float* b_ada, float* mod) {
    float (*sc)[1024] = (float (*)[1024])lds;
    float (*red)[9][64] = (float (*)[9][64])(lds + 9 * 1024 * 4);
    const int t = tid, l = vb / 96, n0 = (vb % 96) * 64;
    __syncthreads();
    for (int i = t; i < 9 * 1024; i += 512) { const int j = i >> 10, k = i & 1023; const float v = j < 8 ? c[j * 1024 + k] : c_ctx[k]; sc[j][k] = v / (1.0f + expf(-v)); }
    __syncthreads();
    const int col = t & 63, ks = t >> 6;
    float acc[9];
#pragma unroll
    for (int j = 0; j < 9; ++j) acc[j] = 0.f;
    const float* w = w_ada + (size_t)l * 1024 * 6144 + n0 + col;
    for (int k = ks * 128; k < ks * 128 + 128; ++k) {
        const float wv = w[(size_t)k * 6144];
#pragma unroll
        for (int j = 0; j < 9; ++j) acc[j] += sc[j][k] * wv;
    }
#pragma unroll
    for (int j = 0; j < 9; ++j) red[ks][j][col] = acc[j];
    __syncthreads();
    for (int i = t; i < 9 * 64; i += 512) {
        const int j = i >> 6, cc = i & 63; float s = 0.f;
#pragma unroll
        for (int q = 0; q < 8; ++q) s += red[q][j][cc];
        mod[(size_t)(l * 9 + j) * 6144 + n0 + cc] = s + b_ada[l * 6144 + n0 + cc];
    }
}

__device__ __forceinline__ void b_rot(int tid, int vb, float* rot) {
    const int i = vb * 512 + tid; if (i >= SEQ * 64) return;
    const int n = i >> 6, i2 = i & 63;
    const float inv = powf(10000.0f, -(float)(i2 & 31) / 32.0f);
    const float pos = (i2 < 32) ? (float)(n >> 6) : (float)(n & 63);
    const float ang = pos * inv; float s, c; sincosf(ang, &s, &c);
    rot[2 * i] = c; rot[2 * i + 1] = s;
}

__device__ __forceinline__ void norm_mod_row(const float* src, const float* gvec, const float* sc, const float* sh, int lane, f32x4 (&v)[4]) {
    float ss = 0.f;
#pragma unroll
    for (int j = 0; j < 4; ++j) { v[j] = *(const f32x4*)(src + 4 * lane + 256 * j); ss += (v[j].x * v[j].x + v[j].y * v[j].y) + (v[j].z * v[j].z + v[j].w * v[j].w); }
    const float rstd = 1.0f / sqrtf(wave_sum(ss) * (1.0f / 1024.0f) + EPS);
#pragma unroll
    for (int j = 0; j < 4; ++j) {
        const f32x4 g = *(const f32x4*)(gvec + 4 * lane + 256 * j), s1 = *(const f32x4*)(sc + 4 * lane + 256 * j), s0 = *(const f32x4*)(sh + 4 * lane + 256 * j);
        v[j] = (v[j] * rstd * g) * (1.0f + s1) + s0;
    }
}
__device__ __forceinline__ void store_row_bf16(bf16_t* dst, int lane, const f32x4 (&v)[4]) {
#pragma unroll
    for (int j = 0; j < 4; ++j) { u32x2 w; w.x = pk2(v[j].x, v[j].y); w.y = pk2(v[j].z, v[j].w); *(u32x2*)(dst + 4 * lane + 256 * j) = w; }
}

__device__ __forceinline__ void b_norm1(int tid, int vb, const float* xs, const float* cs, const float* gvec, const float* mod_l, bf16_t* h) {
    const int lane = tid & 63, R = vb * 8 + (tid >> 6); if (R >= MT) return;
    const RowInfo ri = rinfo(R);
    const float* src = ri.is_ctx ? cs + (size_t)ri.nat * D : xs + (size_t)ri.nat * D;
    f32x4 v[4]; norm_mod_row(src, gvec, mod_l + ri.mj * 6144 + 1024, mod_l + ri.mj * 6144 + 0, lane, v);
    store_row_bf16(h + (size_t)R * D, lane, v);
}

__device__ __forceinline__ void b_offsets(int tid, const unsigned* cnt, unsigned* base) {
    __syncthreads();
    if (tid == 0) { unsigned b = 0; for (int e = 0; e < NEXP; ++e) { base[e] = b; b += ((__hip_atomic_load(cnt + e, __ATOMIC_RELAXED, __HIP_MEMORY_SCOPE_AGENT) + 255u) / 256u) * 256u; } base[NEXP] = b; }
    __syncthreads();
}

template <class F> __device__ __forceinline__ void b_gemm(int tid, char* lds, int bx, int by, const F f) {
    float (*As)[132] = (float (*)[132])lds;
    float (*Bs)[68] = (float (*)[68])(lds + 16 * 132 * 4);
    const int t = tid, row0 = by * 128, col0 = bx * 64;
    if (!f.tile_active(row0)) return;
    const float* B = f.b_ptr(row0); const int ldb = f.ldb(), K = f.K();
    const int tm = t >> 4, tn = t & 15;
    float acc[4][4];
#pragma unroll
    for (int i = 0; i < 4; ++i)
#pragma unroll
        for (int j = 0; j < 4; ++j) acc[i][j] = 0.f;
    const int ar = t >> 2, ak = (t & 3) * 4;
    const bf16_t* arow = f.a_row(row0 + ar);
    const int bk = t >> 5, bn = (t & 31) * 2;
    for (int k0 = 0; k0 < K; k0 += 16) {
        const u32x2 av = *(const u32x2*)(arow + k0 + ak);
        As[ak + 0][ar] = bf2f((bf16_t)(av.x & 0xffffu)); As[ak + 1][ar] = bf2f((bf16_t)(av.x >> 16));
        As[ak + 2][ar] = bf2f((bf16_t)(av.y & 0xffffu)); As[ak + 3][ar] = bf2f((bf16_t)(av.y >> 16));
        const f32x2 bv = *(const f32x2*)(B + (size_t)(k0 + bk) * ldb + col0 + bn);
        Bs[bk][bn] = bv.x; Bs[bk][bn + 1] = bv.y;
        __syncthreads();
#pragma unroll
        for (int kk = 0; kk < 16; ++kk) {
            float a[4], b[4];
#pragma unroll
            for (int i = 0; i < 4; ++i) { a[i] = As[kk][tm * 4 + i]; b[i] = Bs[kk][tn * 4 + i]; }
#pragma unroll
            for (int i = 0; i < 4; ++i)
#pragma unroll
                for (int j = 0; j < 4; ++j) acc[i][j] += a[i] * b[j];
        }
        __syncthreads();
    }
#pragma unroll
    for (int i = 0; i < 4; ++i) f.epi(row0 + tm * 4 + i, col0 + tn * 4, (f32x4){acc[i][0], acc[i][1], acc[i][2], acc[i][3]});
}

__device__ __forceinline__ void b_sgu(int tid, char* lds, int c, int g, bf16_t* P, const float* w_s_l, const float* b_s_l, const float* g_sgu_l) {
    float* sm = (float*)lds;
    float* vn = sm; float* w = sm + 128 * 128; float* mu = w + 128 * 129; float* rs = mu + 128;
    const int t = tid, lane = t & 63, wv = t >> 6;
    __syncthreads();
    const int row0 = c < GB * 32 ? (c >> 5) * SEQ + (c & 31) * CH : GX + ((c - GB * 32) >> 1) * CTXL + ((c - GB * 32) & 1) * CH;
    for (int r = wv * 16; r < wv * 16 + 16; ++r) {
        const bf16_t* src = P + (size_t)(row0 + r) * DIN + C_VA; float s = 0.f, s2 = 0.f;
#pragma unroll
        for (int j = 0; j < 16; ++j) { const float x = bf2f(src[lane + 64 * j]); s += x; s2 += x * x; }
        s = wave_sum(s); s2 = wave_sum(s2);
        const float m = s * (1.0f / 1024.0f), var = s2 * (1.0f / 1024.0f) - m * m;
        if (lane == 0) { mu[r] = m; rs[r] = 1.0f / sqrtf(fmaxf(var, 0.f) + EPS); }
    }
    __syncthreads();
    for (int i = t; i < 128 * 128; i += 512) { const int q = i >> 7, cc = i & 127;
        vn[i] = (bf2f(P[(size_t)(row0 + q) * DIN + C_VA + g * 128 + cc]) - mu[q]) * rs[q] * g_sgu_l[g * 128 + cc];
        w[q * 129 + cc] = w_s_l[(size_t)g * 128 * 128 + i]; }
    __syncthreads();
    const int p = t >> 2, c0 = (t & 3) * 32;
    float acc[32];
#pragma unroll
    for (int j = 0; j < 32; ++j) acc[j] = 0.f;
    for (int q = 0; q < 128; ++q) { const float wq = w[p * 129 + q];
#pragma unroll
        for (int j = 0; j < 32; ++j) acc[j] += wq * vn[q * 128 + c0 + j]; }
    const float bs = b_s_l[g * 128 + p];
    bf16_t* dst = P + (size_t)(row0 + p) * DIN + C_U + g * 128 + c0;
#pragma unroll
    for (int j = 0; j < 32; ++j) dst[j] = (bf16_t)f2bf(bf2f(dst[j]) * (acc[j] + bs));
}

__device__ __forceinline__ void b_ret(int tid, char* lds, int bx, int hh, int lb, bf16_t* P, const float* decay_l, int is_ctx_seq) {
    float (*qs)[129] = (float (*)[129])lds;
    float (*ks)[129] = (float (*)[129])(lds + 32 * 129 * 4);
    bf16_t (*vs)[256] = (bf16_t (*)[256])(lds + 2 * 32 * 129 * 4);
    float (*ps)[33] = (float (*)[33])(lds + 2 * 32 * 129 * 4 + 32 * 256 * 2);
    const int t = tid, n0 = bx * 32;
    __syncthreads();
    const int N = is_ctx_seq ? CTXL : SEQ;
    const int seq_row0 = is_ctx_seq ? GX + lb * CTXL : lb * SEQ, ctx_row0 = GX + lb * CTXL;
    const float df = decay_l[hh], db = decay_l[4 + hh];
    const float lgf = -log1pf(expf(-df)), lgb = -log1pf(expf(-db));
    { const int r = t >> 4, c8 = (t & 15) * 8; const bf16_t* src = P + (size_t)(seq_row0 + n0 + r) * DIN + C_Q + hh * DK + c8;
#pragma unroll
      for (int j = 0; j < 8; ++j) qs[r][c8 + j] = bf2f(src[j]); }
    const int orow = t >> 4, e0 = (t & 15) * 16;
    const int sn = t >> 4, sm0 = (t & 15) * 2;
    float acc[16];
#pragma unroll
    for (int j = 0; j < 16; ++j) acc[j] = 0.f;
    const int n_ctx_tiles = is_ctx_seq ? 0 : CTXL / 32, n_tiles = n_ctx_tiles + N / 32;
    for (int tile = 0; tile < n_tiles; ++tile) {
        const bool from_ctx = tile < n_ctx_tiles;
        const int m0 = from_ctx ? tile * 32 : (tile - n_ctx_tiles) * 32;
        const int krow0 = from_ctx ? ctx_row0 + m0 : seq_row0 + m0;
        __syncthreads();
        { const int r = t >> 4, c8 = (t & 15) * 8; const bf16_t* src = P + (size_t)(krow0 + r) * DIN + C_K + hh * DK + c8;
#pragma unroll
          for (int j = 0; j < 8; ++j) ks[r][c8 + j] = bf2f(src[j]);
          const bf16_t* vsrc = P + (size_t)(krow0 + r) * DIN + C_V + hh * DV + (t & 15) * 16;
          *(u32x4*)&vs[r][(t & 15) * 16] = *(const u32x4*)vsrc; *(u32x4*)&vs[r][(t & 15) * 16 + 8] = *(const u32x4*)(vsrc + 8); }
        __syncthreads();
        float s0 = 0.f, s1 = 0.f;
#pragma unroll 8
        for (int d = 0; d < 128; ++d) { const float qv = qs[sn][d]; s0 += qv * ks[sm0][d]; s1 += qv * ks[sm0 + 1][d]; }
        const int n = n0 + sn;
#pragma unroll
        for (int u = 0; u < 2; ++u) { const int m = m0 + sm0 + u; float wgt;
            if (from_ctx) wgt = expf(lgf * (float)(n + CTXL - m)) + expf(lgb * (float)(N - n + m));
            else wgt = (m <= n) ? expf(lgf * (float)(n - m)) : expf(lgb * (float)(m - n));
            ps[sn][sm0 + u] = (u == 0 ? s0 : s1) * wgt; }
        __syncthreads();
#pragma unroll 4
        for (int mm = 0; mm < 32; ++mm) { const float pv = ps[orow][mm];
#pragma unroll
            for (int j = 0; j < 16; ++j) acc[j] += pv * bf2f(vs[mm][e0 + j]); }
    }
    float s = 0.f;
#pragma unroll
    for (int j = 0; j < 16; ++j) s += acc[j];
    s += __shfl_xor(s, 1); s += __shfl_xor(s, 2); s += __shfl_xor(s, 4); s += __shfl_xor(s, 8);
    const float mean = s * (1.0f / 256.0f); float q2 = 0.f;
#pragma unroll
    for (int j = 0; j < 16; ++j) { const float d = acc[j] - mean; q2 += d * d; }
    q2 += __shfl_xor(q2, 1); q2 += __shfl_xor(q2, 2); q2 += __shfl_xor(q2, 4); q2 += __shfl_xor(q2, 8);
    const float rstd = 1.0f / sqrtf(q2 * (1.0f / 256.0f) + EPS);
    bf16_t* dst = P + (size_t)(seq_row0 + n0 + orow) * DIN + C_GR + hh * DV + e0;
#pragma unroll
    for (int j = 0; j < 16; ++j) dst[j] = (bf16_t)f2bf(bf2f(dst[j]) * ((acc[j] - mean) * rstd));
}

__device__ __forceinline__ void b_combine(int tid, int vb, float* xres, float* cres, const bf16_t* Y, const unsigned* base, const int* tok_e, const int* tok_p, const float* tok_w,
                                                  const float* mod_l, int with_ctx, int last, const float* gnext, const float* mod_next, bf16_t* h, const float* g_final) {
    const int lane = tid & 63, R = vb * 8 + (tid >> 6); if (R >= MT) return;
    const RowInfo ri = rinfo(R); if (ri.is_ctx && !with_ctx) return;
    float* xr = ri.is_ctx ? cres + (size_t)ri.nat * D : xres + (size_t)ri.nat * D;
    const unsigned sa = base[tok_e[2 * R]] + (unsigned)tok_p[2 * R], sb = base[tok_e[2 * R + 1]] + (unsigned)tok_p[2 * R + 1];
    const float wa = tok_w[2 * R], wb = tok_w[2 * R + 1];
    const float* gt2 = mod_l + ri.mj * 6144 + 5 * 1024;
    f32x4 v[4]; float ss = 0.f;
#pragma unroll
    for (int j = 0; j < 4; ++j) {
        const int c = 4 * lane + 256 * j;
        const u32x2 ya = *(const u32x2*)(Y + (size_t)sa * D + c), yb = *(const u32x2*)(Y + (size_t)sb * D + c);
        f32x4 y; y.x = wa * bf2f((bf16_t)(ya.x & 0xffffu)) + wb * bf2f((bf16_t)(yb.x & 0xffffu)); y.y = wa * bf2f((bf16_t)(ya.x >> 16)) + wb * bf2f((bf16_t)(yb.x >> 16));
        y.z = wa * bf2f((bf16_t)(ya.y & 0xffffu)) + wb * bf2f((bf16_t)(yb.y & 0xffffu)); y.w = wa * bf2f((bf16_t)(ya.y >> 16)) + wb * bf2f((bf16_t)(yb.y >> 16));
        v[j] = *(const f32x4*)(xr + c) + *(const f32x4*)(gt2 + c) * y;
        ss += (v[j].x * v[j].x + v[j].y * v[j].y) + (v[j].z * v[j].z + v[j].w * v[j].w);
    }
    const float rstd = 1.0f / sqrtf(wave_sum(ss) * (1.0f / 1024.0f) + EPS);
    if (last) {
#pragma unroll
        for (int j = 0; j < 4; ++j) { const int c = 4 * lane + 256 * j; *(f32x4*)(xr + c) = v[j] * rstd * *(const f32x4*)(g_final + c); }
    } else {
        const float* sc = mod_next + ri.mj * 6144 + 1024; const float* sh = mod_next + ri.mj * 6144;
        f32x4 o[4];
#pragma unroll
        for (int j = 0; j < 4; ++j) { const int c = 4 * lane + 256 * j; *(f32x4*)(xr + c) = v[j];
            o[j] = (v[j] * rstd * *(const f32x4*)(gnext + c)) * (1.0f + *(const f32x4*)(sc + c)) + *(const f32x4*)(sh + c); }
        store_row_bf16(h + (size_t)R * D, lane, o);
    }
}
}
namespace nv {
template <class E> struct FDense {
    const bf16_t* A; int lda; const float* B; int ldb_, K_; E e;
    __device__ __forceinline__ int K() const { return K_; }
    __device__ __forceinline__ int ldb() const { return ldb_; }
    __device__ __forceinline__ bool tile_active(int) const { return true; }
    __device__ __forceinline__ const float* b_ptr(int) const { return B; }
    __device__ __forceinline__ const bf16_t* a_row(int r) const { return A + (size_t)r * lda; }
    __device__ __forceinline__ void epi(int r, int c, f32x4 v) const { e(r, c, v); }
};
struct MoeCtx { const unsigned* cnt; const unsigned* base; const int* list; };
__device__ __forceinline__ int moe_expert_of(const unsigned* base, unsigned slot) { int e = 0;
#pragma unroll 1
    for (int i = 1; i < NEXP; ++i) if (base[i] <= slot) e = i; return e; }
struct FMoe1 {
    MoeCtx m; const bf16_t* h2; const float* W; float* G1; bf16_t* Hout; int second;
    __device__ __forceinline__ int K() const { return D; }
    __device__ __forceinline__ int ldb() const { return EFF; }
    __device__ __forceinline__ bool tile_active(int row0) const { return (unsigned)row0 < m.base[NEXP]; }
    __device__ __forceinline__ const float* b_ptr(int row0) const { return W + (size_t)moe_expert_of(m.base, (unsigned)row0) * D * EFF; }
    __device__ __forceinline__ const bf16_t* a_row(int r) const { const int e = moe_expert_of(m.base, (unsigned)r); const unsigned pos = (unsigned)r - m.base[e];
        const int tok = pos < m.cnt[e] ? m.list[(size_t)e * MT + pos] : 0; return h2 + (size_t)tok * D; }
    __device__ __forceinline__ void epi(int r, int c, f32x4 v) const {
        if (!second) *(f32x4*)(G1 + (size_t)r * EFF + c) = v;
        else { const f32x4 a = *(const f32x4*)(G1 + (size_t)r * EFF + c); st4bf(Hout + (size_t)r * EFF + c, (f32x4){siluf_(a.x) * v.x, siluf_(a.y) * v.y, siluf_(a.z) * v.z, siluf_(a.w) * v.w}); }
    }
};
struct FMoe2 {
    MoeCtx m; const bf16_t* Hin; const float* W; bf16_t* Y;
    __device__ __forceinline__ int K() const { return EFF; }
    __device__ __forceinline__ int ldb() const { return D; }
    __device__ __forceinline__ bool tile_active(int row0) const { return (unsigned)row0 < m.base[NEXP]; }
    __device__ __forceinline__ const float* b_ptr(int row0) const { return W + (size_t)moe_expert_of(m.base, (unsigned)row0) * EFF * D; }
    __device__ __forceinline__ const bf16_t* a_row(int r) const { return Hin + (size_t)r * EFF; }
    __device__ __forceinline__ void epi(int r, int c, f32x4 v) const { st4bf(Y + (size_t)r * D + c, v); }
};
}

struct Ptrs {
    const float *x, *c, *ctx, *c_ctx, *w_ada, *b_ada, *g_mix, *g_ffn, *w_in, *w_s, *b_s, *g_sgu, *decay, *w_pa, *w_pb, *w_out, *w_group, *b_group, *w_er, *b_er, *w1, *w3, *w2, *g_final;
    float* out; unsigned char* ws;
    unsigned* ctl; float* mod; float* cres; float* rot; bf16_t* h; bf16_t* P; bf16_t* KV;
    int *tok_e, *tok_p; float* tok_w; int* list;
};
__host__ __device__ static inline Ptrs make_ptrs(void* const* d_in, void* d_out, void* d_ws) {
    Ptrs p{}; const float* const* in = (const float* const*)d_in;
    p.x = in[0]; p.c = in[1]; p.ctx = in[2]; p.c_ctx = in[3]; p.w_ada = in[4]; p.b_ada = in[5]; p.g_mix = in[6]; p.g_ffn = in[7]; p.w_in = in[8]; p.w_s = in[9]; p.b_s = in[10]; p.g_sgu = in[11];
    p.decay = in[12]; p.w_pa = in[13]; p.w_pb = in[14]; p.w_out = in[15]; p.w_group = in[16]; p.b_group = in[17]; p.w_er = in[18]; p.b_er = in[19]; p.w1 = in[20]; p.w3 = in[21]; p.w2 = in[22]; p.g_final = in[23];
    p.out = (float*)d_out; p.ws = (unsigned char*)d_ws;
    p.ctl = (unsigned*)(p.ws + WS_CTL); p.mod = (float*)(p.ws + WS_MOD); p.cres = (float*)(p.ws + WS_CTXRES); p.rot = (float*)(p.ws + WS_ROT);
    p.h = (bf16_t*)(p.ws + WS_H); p.P = (bf16_t*)(p.ws + WS_P); p.KV = (bf16_t*)(p.ws + WS_KV);
    p.tok_e = (int*)(p.ws + WS_TAB + TAB_TOKE); p.tok_p = (int*)(p.ws + WS_TAB + TAB_TOKP); p.tok_w = (float*)(p.ws + WS_TAB + TAB_TOKW); p.list = (int*)(p.ws + WS_TAB + TAB_LIST);
    return p;
}

#define GAS __attribute__((address_space(1)))
#define LAS __attribute__((address_space(3)))
constexpr int NWAVES = 8;
constexpr int LDS_BYTES = 155648;
constexpr int LDSCTL_OFF = 154624;
constexpr int LDS_BASE_OFF = LDSCTL_OFF;
constexpr int LDS_MISC_OFF = LDSCTL_OFF + 512;

#define XB_TMO      128
#define XB_XCNT(j)  (256  + 64 * (j))
#define XB_XSUB(j)  (1280 + 64 * (j))
#define XB_XGEN(j)  (2304 + 64 * (j))
#define XB_TOP      3328
#define XB_TOPGEN   3392
#define XCD_BAR_WORDS 3456
#define XB_SPIN_CAP (1u << 24)
__device__ __forceinline__ unsigned xb_ld(unsigned* p)              { return __hip_atomic_load(p, __ATOMIC_RELAXED, __HIP_MEMORY_SCOPE_AGENT); }
__device__ __forceinline__ unsigned xb_add(unsigned* p, unsigned v) { return __hip_atomic_fetch_add(p, v, __ATOMIC_RELAXED, __HIP_MEMORY_SCOPE_AGENT); }
__device__ __forceinline__ unsigned xb_xcc_id() { return (unsigned)__builtin_amdgcn_s_getreg((3 << 11) | 20) & 0xFu; }
#define XB_SPIN(cond, bar) do { unsigned _sp = 0; while (cond) { __builtin_amdgcn_s_sleep(1); \
    if ((++_sp & 255u) == 0u) { if (xb_ld(&(bar)[XB_TMO])) break; if (_sp > XB_SPIN_CAP) { atomicAdd(&(bar)[XB_TMO], 1u); break; } } } } while (0)
struct XcdBarrier { unsigned* bar; unsigned x; volatile LAS unsigned* st; };
__device__ __forceinline__ XcdBarrier xcd_barrier_post(unsigned* bar, volatile LAS unsigned* st) {
    XcdBarrier b; b.bar = bar; b.x = xb_xcc_id(); b.st = st;
    if (threadIdx.x == 0) (void)xb_add(&bar[XB_XCNT(b.x)], 1u);
    return b;
}
__device__ __forceinline__ void xcd_barrier_complete(unsigned* bar, unsigned x, unsigned& nloc, unsigned& nx) {
    const unsigned G = gridDim.x * gridDim.y * gridDim.z;
    unsigned sum, cnt, mine, sp = 0u;
    for (;;) {
        sum = 0u; cnt = 0u; mine = 0u;
#pragma unroll
        for (unsigned j = 0; j < 16; ++j) { const unsigned c = xb_ld(&bar[XB_XCNT(j)]); sum += c; cnt += (c > 0u) ? 1u : 0u; mine = (j == x) ? c : mine; }
        if (sum == G) break;
        __builtin_amdgcn_s_sleep(1);
        if ((++sp & 255u) == 0u) { if (xb_ld(&bar[XB_TMO])) break; if (sp > XB_SPIN_CAP) { atomicAdd(&bar[XB_TMO], 1u); break; } }
    }
    nloc = mine > 0u ? mine : 1u; nx = cnt > 0u ? cnt : 1u;
}
__device__ __forceinline__ void xcd_barrier(const XcdBarrier& b) {
    asm volatile("s_waitcnt vmcnt(0)" ::: "memory");
    __syncthreads();
    if (threadIdx.x == 0) {
        unsigned* bar = b.bar;
        __builtin_amdgcn_s_waitcnt(0);
        unsigned nloc = b.st[0], nx = b.st[1];
        if (nloc == 0u) { xcd_barrier_complete(bar, b.x, nloc, nx); b.st[0] = nloc; b.st[1] = nx; }
        const unsigned old = xb_add(&bar[XB_XSUB(b.x)], 1u);
        const unsigned gen = old / nloc;
        if (old + 1u == (gen + 1u) * nloc) {
            __builtin_amdgcn_fence(__ATOMIC_RELEASE, "agent");
            asm volatile("s_waitcnt vmcnt(0)" ::: "memory");
            const unsigned og = xb_add(&bar[XB_TOP], 1u);
            const unsigned tg = og / nx;
            if (og + 1u == (tg + 1u) * nx) xb_add(&bar[XB_TOPGEN], 1u);
            else XB_SPIN(xb_ld(&bar[XB_TOPGEN]) == tg, bar);
            __builtin_amdgcn_fence(__ATOMIC_ACQUIRE, "agent");
            xb_add(&bar[XB_XGEN(b.x)], 1u);
            asm volatile("s_waitcnt vmcnt(0)" ::: "memory");
        } else {
            XB_SPIN(xb_ld(&bar[XB_XGEN(b.x)]) == gen, bar);
            __builtin_amdgcn_fence(__ATOMIC_ACQUIRE, "agent");
            asm volatile("s_waitcnt vmcnt(0)" ::: "memory");
        }
    }
    __syncthreads();
}
__device__ __forceinline__ int router_perm_k(int idx) { return 4 * (idx & 63) + ((idx >> 6) & 3) + 256 * (idx >> 8); }
__device__ __forceinline__ void norm2_phase(int tid, char* lds, int bid, int G, const float* xs, const float* cs, const float* gvec, const float* mod_l, bf16_t* h,
                                            const float* w_group, const float* b_group, const float* w_er, const float* b_er,
                                            unsigned* cnt, int* tok_e, int* tok_p, float* tok_w, int* list, int with_ctx) {
    f32x4* Wg4 = (f32x4*)lds; f32x4* We4 = (f32x4*)(lds + 16384);
    __syncthreads();
    for (int idx = tid; idx < 1024; idx += 512) Wg4[idx] = *(const f32x4*)(w_group + (size_t)router_perm_k(idx) * 4);
    for (int i = tid; i < 8192; i += 512) { const int idx = i >> 3, c = i & 7, g = c >> 1, hf = c & 1;
        We4[(g * 2 + hf) * 1024 + idx] = *(const f32x4*)(w_er + (size_t)router_perm_k(idx) * 32 + c * 4); }
    __syncthreads();
    const int lane = tid & 63, wv = tid >> 6;
    const f32x4 bg = *(const f32x4*)b_group;
    for (int R = bid * 8 + wv; R < MT; R += G * 8) {
        const RowInfo ri = rinfo(R); if (ri.is_ctx && !with_ctx) continue;
        const float* src = ri.is_ctx ? cs + (size_t)ri.nat * D : xs + (size_t)ri.nat * D;
        f32x4 v[4]; nv::norm_mod_row(src, gvec, mod_l + ri.mj * 6144 + 4 * 1024, mod_l + ri.mj * 6144 + 3 * 1024, lane, v);
        nv::store_row_bf16(h + (size_t)R * D, lane, v);
        f32x4 gl = (f32x4){0.f, 0.f, 0.f, 0.f};
#pragma unroll
        for (int j = 0; j < 4; ++j)
#pragma unroll
            for (int e = 0; e < 4; ++e) gl += Wg4[(j * 4 + e) * 64 + lane] * v[j][e];
        gl.x = wave_sum(gl.x) + bg.x; gl.y = wave_sum(gl.y) + bg.y; gl.z = wave_sum(gl.z) + bg.z; gl.w = wave_sum(gl.w) + bg.w;
        int gs = 0; float gt = gl.x;
        if (gl.y > gt) { gt = gl.y; gs = 1; } if (gl.z > gt) { gt = gl.z; gs = 2; } if (gl.w > gt) { gt = gl.w; gs = 3; }
        const float pg = 1.0f / (expf(gl.x - gt) + expf(gl.y - gt) + expf(gl.z - gt) + expf(gl.w - gt));
        gs = __builtin_amdgcn_readfirstlane(gs);
        f32x4 ea = (f32x4){0.f, 0.f, 0.f, 0.f}, eb = ea;
        const f32x4* Wa = We4 + (gs * 2) * 1024; const f32x4* Wb = Wa + 1024;
#pragma unroll
        for (int j = 0; j < 4; ++j)
#pragma unroll
            for (int e = 0; e < 4; ++e) { ea += Wa[(j * 4 + e) * 64 + lane] * v[j][e]; eb += Wb[(j * 4 + e) * 64 + lane] * v[j][e]; }
        const f32x4 be0 = *(const f32x4*)(b_er + gs * 8), be1 = *(const f32x4*)(b_er + gs * 8 + 4);
        float eg[8];
        eg[0] = wave_sum(ea.x) + be0.x; eg[1] = wave_sum(ea.y) + be0.y; eg[2] = wave_sum(ea.z) + be0.z; eg[3] = wave_sum(ea.w) + be0.w;
        eg[4] = wave_sum(eb.x) + be1.x; eg[5] = wave_sum(eb.y) + be1.y; eg[6] = wave_sum(eb.z) + be1.z; eg[7] = wave_sum(eb.w) + be1.w;
        int i0 = 0; float e0 = eg[0];
#pragma unroll
        for (int j = 1; j < 8; ++j) if (eg[j] > e0) { e0 = eg[j]; i0 = j; }
        int i1 = -1; float e1 = -3.0e38f;
#pragma unroll
        for (int j = 0; j < 8; ++j) if (j != i0 && eg[j] > e1) { e1 = eg[j]; i1 = j; }
        const float x1 = expf(e1 - e0), w0 = pg / (1.0f + x1), w1 = pg * x1 / (1.0f + x1);
        if (lane == 0) {
            const int ex = gs * 8 + i0, ey = gs * 8 + i1;
            const int pa = (int)atomicAdd(cnt + ex, 1u), pb = (int)atomicAdd(cnt + ey, 1u);
            list[(size_t)ex * MT + pa] = R; list[(size_t)ey * MT + pb] = R;
            tok_e[2 * R] = ex; tok_e[2 * R + 1] = ey; tok_p[2 * R] = pa; tok_p[2 * R + 1] = pb; tok_w[2 * R] = w0; tok_w[2 * R + 1] = w1;
        }
    }
}
namespace pg8 {
#define PG8_LAS __attribute__((address_space(3)))
constexpr int BM = 256, BK = 64, HALF = 128, HTB = HALF * BK * 2, STAGE_BYTES = 8 * HTB, NXCD = 8, WGM = 8;
__host__ __device__ __forceinline__ int lds_byte(int r, int c) { const int st = (r >> 4) * 2 + (c >> 5), rr = r & 15, cc = c & 31, ob = rr * 64 + cc * 2; return st * 1024 + (ob ^ (((ob >> 9) & 1) << 5)); }
__host__ __device__ __forceinline__ void stage_rc(int b, int& R, int& C) { const int st = b / 1024, sb = b % 1024, swz = sb ^ (((sb >> 9) & 1) << 5); R = (st >> 1) * 16 + swz / 64; C = (st & 1) * 32 + (swz % 64) / 2; }
struct Unit { int pm, pn, aux; };
struct TileOrder {
    int nM, nN, nwg, G, c;
    __device__ __forceinline__ void init(int nM_, int nN_, int G_, int c_) { nM = nM_; nN = nN_; nwg = nM * nN; G = G_; c = c_; }
    __device__ __forceinline__ bool tile(int i, int& pm, int& pn) const {
        const long L = (long)i * G + c; if (L >= nwg) return false;
        int wgid = (int)L; { const int q = nwg / NXCD, r = nwg % NXCD, xcd = wgid % NXCD, off = wgid / NXCD; wgid = (xcd < r ? xcd * (q + 1) : r * (q + 1) + (xcd - r) * q) + off; }
        const int nig = WGM * nN, gid = wgid / nig, fm = gid * WGM, gsz = (nM - fm) < WGM ? (nM - fm) : WGM;
        pm = fm + ((wgid % nig) % gsz); pn = (wgid % nig) / gsz; return true;
    }
};

template <class Epi, class Sched, bool ALIGN_EPI>
__device__ __forceinline__ void gemm_phase(int tid, PG8_LAS unsigned char* lds, const Sched& S, const Epi& E, const int K) {
    const int wid = __builtin_amdgcn_readfirstlane(tid >> 6), lane = tid & 63, wr = wid >> 2, wc = wid & 3, fr = lane & 15, fq = lane >> 4;
    const int nt = K / BK;
    int RA[2], CA[2]; unsigned voffB[2];
#pragma unroll
    for (int i = 0; i < 2; ++i) { stage_rc(tid * 16 + i * 8192, RA[i], CA[i]); voffB[i] = (unsigned)(RA[i] * K + CA[i]) * 2u; }
    const size_t kstep = (size_t)(BK * 2);
    const size_t hstepB = (size_t)HALF * K * 2;
    const unsigned ldsw = (unsigned)wid * 1024u;
    const int aoff = lds_byte(wr * 64 + fr, fq * 8), boff = lds_byte(wc * 32 + fr, fq * 8);
#define PG8_SA(b, h) (((b) * 2 + (h)) * HTB)
#define PG8_SB(b, h) ((4 + (b) * 2 + (h)) * HTB)
#define PG8_STAGE(bufoff, gbase, voff) do { _Pragma("unroll") for (int _i = 0; _i < 2; ++_i) \
        __builtin_amdgcn_global_load_lds((const unsigned*)((const char*)(gbase) + (voff)[_i]), (PG8_LAS unsigned*)(lds + (bufoff) + ldsw + _i * 8192), 16, 0, 0); } while (0)
#define PG8_LDA(dst, b, h) do { _Pragma("unroll") for (int m = 0; m < 4; ++m) _Pragma("unroll") for (int k = 0; k < 2; ++k) dst[m][k] = *(const PG8_LAS bf16x8*)(lds + PG8_SA(b, h) + aoff + m * 2048 + k * 1024); } while (0)
#define PG8_LDB(dst, b, h) do { _Pragma("unroll") for (int n = 0; n < 2; ++n) _Pragma("unroll") for (int k = 0; k < 2; ++k) dst[n][k] = *(const PG8_LAS bf16x8*)(lds + PG8_SB(b, h) + boff + n * 2048 + k * 1024); } while (0)
#define PG8_MMA(ai, bj, At, Bt) do { __builtin_amdgcn_s_setprio(1); _Pragma("unroll") for (int m = 0; m < 4; ++m) _Pragma("unroll") for (int n = 0; n < 2; ++n) _Pragma("unroll") for (int k = 0; k < 2; ++k) \
        acc[ai][bj][m][n] = __builtin_amdgcn_mfma_f32_16x16x32_bf16(Bt[n][k], At[m][k], acc[ai][bj][m][n], 0, 0, 0); __builtin_amdgcn_s_setprio(0); } while (0)
#define PG8_WAIT_V(n) asm volatile("s_waitcnt vmcnt(" #n ")" ::: "memory")
#define PG8_WAIT_L(n) asm volatile("s_waitcnt lgkmcnt(" #n ")" ::: "memory")
#define PG8_BAR __builtin_amdgcn_s_barrier()
#define PG8_SCHED __builtin_amdgcn_sched_barrier(0)
#define PG8_AOFFS(dst, u) do { _Pragma("unroll") for (int _h = 0; _h < 2; ++_h) _Pragma("unroll") for (int _i = 0; _i < 2; ++_i) dst[_h][_i] = S.a_rowoff(u, _h * HALF + RA[_i]) + (unsigned)CA[_i] * 2u; } while (0)
    Unit cur, nxt; int ui = 0;
    if (!S.next(0, cur)) return;
    f32x4 acc[2][2][4][2];
#pragma unroll
    for (int a = 0; a < 2; ++a)
#pragma unroll
        for (int b = 0; b < 2; ++b)
#pragma unroll
            for (int m = 0; m < 4; ++m)
#pragma unroll
                for (int n = 0; n < 2; ++n) acc[a][b][m][n] = (f32x4){0.f, 0.f, 0.f, 0.f};
    bf16x8 At[4][2], B0[2][2], B1[2][2];
    const char* cA = S.a_base(cur); const char* cB = S.b_base(cur);
    unsigned vc[2][2], vn[2][2];
    PG8_AOFFS(vc, cur);
    PG8_STAGE(PG8_SB(0, 0), cB, voffB); PG8_STAGE(PG8_SB(0, 1), cB + hstepB, voffB); PG8_STAGE(PG8_SA(0, 0), cA, vc[0]); PG8_STAGE(PG8_SA(0, 1), cA, vc[1]);
    if (wr == 1) PG8_BAR;
    PG8_WAIT_V(2); PG8_BAR;
    PG8_STAGE(PG8_SB(1, 0), cB + kstep, voffB); PG8_STAGE(PG8_SA(1, 0), cA + kstep, vc[0]); PG8_STAGE(PG8_SB(1, 1), cB + hstepB + kstep, voffB);
    PG8_WAIT_V(6); PG8_BAR;
    for (;;) {
        const bool has_next = S.next(ui + 1, nxt);
        const char* nA = has_next ? S.a_base(nxt) : cA; const char* nB = has_next ? S.b_base(nxt) : cB;
        if (has_next) { PG8_AOFFS(vn, nxt); } else {
#pragma unroll
            for (int _h = 0; _h < 2; ++_h)
#pragma unroll
                for (int _i = 0; _i < 2; ++_i) vn[_h][_i] = vc[_h][_i]; }
        for (int t = 0; t < nt; t += 2) {
            const bool last = (t == nt - 2);
            const char* a1 = cA + (size_t)(t + 1) * kstep;
            const char* a2 = last ? nA : cA + (size_t)(t + 2) * kstep; const char* b2 = last ? nB : cB + (size_t)(t + 2) * kstep;
            const char* a3 = a2 + kstep; const char* b3 = b2 + kstep;
            unsigned v2[2][2];
#pragma unroll
            for (int _h = 0; _h < 2; ++_h)
#pragma unroll
                for (int _i = 0; _i < 2; ++_i) v2[_h][_i] = last ? vn[_h][_i] : vc[_h][_i];
            PG8_LDB(B0, 0, 0); PG8_LDB(B1, 0, 1); PG8_SCHED; PG8_LDA(At, 0, 0); PG8_STAGE(PG8_SA(1, 1), a1, vc[1]);
            PG8_WAIT_V(8); PG8_WAIT_L(0); PG8_BAR; PG8_MMA(0, 0, At, B0); PG8_MMA(0, 1, At, B1); PG8_BAR; PG8_SCHED;
            PG8_LDA(At, 0, 1); PG8_STAGE(PG8_SB(0, 0), b2, voffB); PG8_STAGE(PG8_SB(0, 1), b2 + hstepB, voffB); PG8_STAGE(PG8_SA(0, 0), a2, v2[0]);
            PG8_WAIT_V(8); PG8_WAIT_L(0); PG8_BAR; PG8_MMA(1, 0, At, B0); PG8_MMA(1, 1, At, B1); PG8_BAR; PG8_SCHED;
            PG8_LDB(B0, 1, 0); PG8_LDB(B1, 1, 1); PG8_SCHED; PG8_LDA(At, 1, 0); PG8_STAGE(PG8_SA(0, 1), a2, v2[1]);
            PG8_WAIT_V(8); PG8_WAIT_L(0); PG8_BAR; PG8_MMA(0, 0, At, B0); PG8_MMA(0, 1, At, B1); PG8_BAR; PG8_SCHED;
            PG8_LDA(At, 1, 1); PG8_STAGE(PG8_SB(1, 0), b3, voffB); PG8_STAGE(PG8_SB(1, 1), b3 + hstepB, voffB); PG8_STAGE(PG8_SA(1, 0), a3, v2[0]);
            PG8_WAIT_V(8); PG8_WAIT_L(0); PG8_BAR; PG8_MMA(1, 0, At, B0); PG8_MMA(1, 1, At, B1); PG8_BAR; PG8_SCHED;
        }
        if constexpr (ALIGN_EPI) { if (wr == 0) PG8_BAR; }
        E(acc, cur, wr, wc, fr, fq);
        if (!has_next) break;
#pragma unroll
        for (int a = 0; a < 2; ++a)
#pragma unroll
            for (int b = 0; b < 2; ++b)
#pragma unroll
                for (int m = 0; m < 4; ++m)
#pragma unroll
                    for (int n = 0; n < 2; ++n) acc[a][b][m][n] = (f32x4){0.f, 0.f, 0.f, 0.f};
        cur = nxt; cA = nA; cB = nB; ++ui;
#pragma unroll
        for (int _h = 0; _h < 2; ++_h)
#pragma unroll
            for (int _i = 0; _i < 2; ++_i) vc[_h][_i] = vn[_h][_i];
        if constexpr (ALIGN_EPI) { if (wr == 1) PG8_BAR; }
    }
    PG8_WAIT_V(0);
    if constexpr (!ALIGN_EPI) { if (wr == 0) PG8_BAR; }
    PG8_BAR;
#undef PG8_SA
#undef PG8_SB
#undef PG8_STAGE
#undef PG8_LDA
#undef PG8_LDB
#undef PG8_MMA
#undef PG8_WAIT_V
#undef PG8_WAIT_L
#undef PG8_BAR
#undef PG8_SCHED
#undef PG8_AOFFS
}

template <class F> __device__ __forceinline__ void epi_elems(const f32x4 (&acc)[2][2][4][2], int row0, int col0, int wr, int wc, int fr, int fq, const F& f) {
#pragma unroll
    for (int ai = 0; ai < 2; ++ai)
#pragma unroll
        for (int m = 0; m < 4; ++m)
#pragma unroll
            for (int bj = 0; bj < 2; ++bj)
#pragma unroll
                for (int n = 0; n < 2; ++n) f(row0 + ai * HALF + wr * 64 + m * 16 + fr, col0 + bj * HALF + wc * 32 + n * 16 + 4 * fq, acc[ai][bj][m][n]);
}
}
__device__ __forceinline__ void transpose_item(const float* W, int N, bf16_t* WT, int ldt, int drow0, LAS float* scr, int k0, int n0, int lane) {
#pragma unroll 8
    for (int i = 0; i < 32; ++i) { const int kk = 2 * i + (lane >> 5); scr[kk * 33 + (lane & 31)] = W[(size_t)(k0 + kk) * N + n0 + (lane & 31)]; }
    asm volatile("s_waitcnt lgkmcnt(0)" ::: "memory");
    const int c = lane & 7;
#pragma unroll
    for (int j = 0; j < 4; ++j) { const int n = (lane >> 3) + 8 * j; const LAS float* s = scr + (8 * c) * 33 + n;
        u32x4 o; o.x = pk2(s[0 * 33], s[1 * 33]); o.y = pk2(s[2 * 33], s[3 * 33]); o.z = pk2(s[4 * 33], s[5 * 33]); o.w = pk2(s[6 * 33], s[7 * 33]);
        *(u32x4*)(WT + (size_t)(drow0 + n) * ldt + k0 + 8 * c) = o; }
    asm volatile("s_waitcnt lgkmcnt(0)" ::: "memory");
}
constexpr int CONV_IN_ITEMS = 16 * 224, CONV_PROJ_ITEMS = 16 * 32, CONV_MOE_ITEMS = NEXP * 768;
__device__ __forceinline__ bf16_t* win_t(const Ptrs& p, int l) { return (bf16_t*)(p.ws + WS_WIN) + (size_t)l * DIN * D; }
__device__ __forceinline__ bf16_t* wproj_t(const Ptrs& p, int l, int j) { return (bf16_t*)(p.ws + WS_WPROJ) + (size_t)(l * 3 + j) * D * D; }
__device__ __forceinline__ bf16_t* w13_t(const Ptrs& p) { return (bf16_t*)(p.ws + WS_WMOE); }
__device__ __forceinline__ bf16_t* w2_t(const Ptrs& p) { return (bf16_t*)(p.ws + WS_WMOE + 64 * MiB); }
__device__ __forceinline__ bf16_t* ws_b(const Ptrs& p, int l) { return (bf16_t*)(p.ws + WS_WS) + (size_t)l * 8 * 128 * 128; }

__device__ __forceinline__ void conv_moe(int tid, char* lds, const Ptrs& p, int l, int bid, int G) {
    const int lane = tid & 63, wv = tid >> 6; LAS float* scr = (LAS float*)(lds + wv * 16384);
    __syncthreads();
    for (int it = bid * 8 + wv; it < CONV_MOE_ITEMS; it += G * 8) {
        const int e = it / 768, r = it % 768;
        if (r < 512) { const int which = r >> 8, r2 = r & 255, kb = r2 >> 4, nb = r2 & 15, n0 = nb * 32;
            const float* W = (which ? p.w3 : p.w1) + ((size_t)l * NEXP + e) * D * EFF;
            transpose_item(W, EFF, w13_t(p) + (size_t)e * 1024 * 1024, 1024, (n0 >> 7) * 256 + which * 128 + (n0 & 127), scr, kb * 64, n0, lane);
        } else { const int r2 = r - 512, kb = r2 >> 5, nb = r2 & 31;
            transpose_item(p.w2 + ((size_t)l * NEXP + e) * EFF * D, D, w2_t(p) + (size_t)e * 1024 * 512, 512, nb * 32, scr, kb * 64, nb * 32, lane); }
    }
}
__device__ __forceinline__ void fast_prologue(int tid, char* lds, const Ptrs& p, int bid, int G) {
    const int lane = tid & 63, wv = tid >> 6; LAS float* scr = (LAS float*)(lds + wv * 16384);
    __syncthreads();
    const int NIT = DEPTH * CONV_IN_ITEMS + DEPTH * 3 * CONV_PROJ_ITEMS;
    for (int it = bid * 8 + wv; it < NIT; it += G * 8) {
        if (it < DEPTH * CONV_IN_ITEMS) { const int l = it / CONV_IN_ITEMS, r = it % CONV_IN_ITEMS, kb = r / 224, nb = r % 224;
            transpose_item(p.w_in + (size_t)l * D * DIN, DIN, win_t(p, l), D, nb * 32, scr, kb * 64, nb * 32, lane);
        } else { const int r0 = it - DEPTH * CONV_IN_ITEMS, m = r0 / CONV_PROJ_ITEMS, r = r0 % CONV_PROJ_ITEMS, l = m / 3, j = m % 3, kb = r >> 5, nb = r & 31;
            const float* W = (j == 0 ? p.w_pa : j == 1 ? p.w_pb : p.w_out) + (size_t)l * D * D;
            transpose_item(W, D, wproj_t(p, l, j), D, nb * 32, scr, kb * 64, nb * 32, lane); }
    }
    conv_moe(tid, lds, p, 0, bid, G);
    for (int i = bid * 512 + tid; i < DEPTH * 8 * 128 * 128 / 4; i += G * 512) { const f32x4 v = *(const f32x4*)(p.w_s + (size_t)i * 4); u32x2 o; o.x = pk2(v.x, v.y); o.y = pk2(v.z, v.w); *(u32x2*)((bf16_t*)(p.ws + WS_WS) + (size_t)i * 4) = o; }
}

struct SchedIn {
    pg8::TileOrder o1, o2; const char* A; const char* B; int n1, G, c, kv_only;
    __device__ __forceinline__ void init(const bf16_t* h_g, const bf16_t* wt, int G_, int c_, int kv_only_) { A = (const char*)h_g; B = (const char*)wt; G = G_; c = c_; kv_only = kv_only_;
        o1.init(GX / 256, DIN / 256, 1, 0); o2.init(GC / 256, kv_only ? 6 : DIN / 256, 1, 0); n1 = o1.nwg; }
    __device__ __forceinline__ bool next(int i, pg8::Unit& u) const { const int L = i * G + c; u.aux = 0;
        if (L < n1) return o1.tile(L, u.pm, u.pn);
        int pm, pn; if (!o2.tile(L - n1, pm, pn)) return false; u.pm = GX / 256 + pm; u.pn = kv_only ? C_K / 256 + pn : pn; return true; }
    __device__ __forceinline__ const char* a_base(const pg8::Unit& u) const { return A + (size_t)u.pm * 256 * D * 2; }
    __device__ __forceinline__ const char* b_base(const pg8::Unit& u) const { return B + (size_t)u.pn * 256 * D * 2; }
    __device__ __forceinline__ unsigned a_rowoff(const pg8::Unit&, int r) const { return (unsigned)r * (D * 2); }
};
struct EpiInT { EpiIn e; __device__ __forceinline__ void operator()(const f32x4 (&acc)[2][2][4][2], const pg8::Unit& u, int wr, int wc, int fr, int fq) const { pg8::epi_elems(acc, u.pm * 256, u.pn * 256, wr, wc, fr, fq, e); } };

struct SchedMerge {
    pg8::TileOrder o; const char* P; const char* Ba; const char* Bb;
    __device__ __forceinline__ bool next(int i2, pg8::Unit& u) const { u.aux = i2 & 1; return o.tile(i2 >> 1, u.pm, u.pn); }
    __device__ __forceinline__ const char* a_base(const pg8::Unit& u) const { return P + ((size_t)u.pm * 256 * DIN + (u.aux ? C_GR : C_U)) * 2; }
    __device__ __forceinline__ const char* b_base(const pg8::Unit& u) const { return (u.aux ? Bb : Ba) + (size_t)u.pn * 256 * D * 2; }
    __device__ __forceinline__ unsigned a_rowoff(const pg8::Unit&, int r) const { return (unsigned)r * (DIN * 2); }
};
struct EpiMergeT { bf16_t* P;
    __device__ __forceinline__ void operator()(const f32x4 (&acc)[2][2][4][2], const pg8::Unit& u, int wr, int wc, int fr, int fq) const {
        if (u.aux == 0) { EpiMergeA e{P}; pg8::epi_elems(acc, u.pm * 256, u.pn * 256, wr, wc, fr, fq, e); }
        else { EpiMergeB e{P}; pg8::epi_elems(acc, u.pm * 256, u.pn * 256, wr, wc, fr, fq, e); } } };
struct SchedOut {
    pg8::TileOrder o; const char* P; const char* B;
    __device__ __forceinline__ bool next(int i, pg8::Unit& u) const { u.aux = 0; return o.tile(i, u.pm, u.pn); }
    __device__ __forceinline__ const char* a_base(const pg8::Unit& u) const { return P + ((size_t)u.pm * 256 * DIN + C_GA) * 2; }
    __device__ __forceinline__ const char* b_base(const pg8::Unit& u) const { return B + (size_t)u.pn * 256 * D * 2; }
    __device__ __forceinline__ unsigned a_rowoff(const pg8::Unit&, int r) const { return (unsigned)r * (DIN * 2); }
};
struct EpiOutT { EpiOut e; __device__ __forceinline__ void operator()(const f32x4 (&acc)[2][2][4][2], const pg8::Unit& u, int wr, int wc, int fr, int fq) const { pg8::epi_elems(acc, u.pm * 256, u.pn * 256, wr, wc, fr, fq, e); } };

struct SchedMoe1 {
    pg8::TileOrder o; const char* h2; const char* W; const unsigned* cnt; const unsigned* base; const int* list;
    __device__ __forceinline__ bool next(int i, pg8::Unit& u) const { if (!o.tile(i, u.pm, u.pn)) return false; u.aux = nv::moe_expert_of(base, (unsigned)u.pm * 256u); return true; }
    __device__ __forceinline__ const char* a_base(const pg8::Unit&) const { return h2; }
    __device__ __forceinline__ const char* b_base(const pg8::Unit& u) const { return W + ((size_t)u.aux * 1024 + (size_t)u.pn * 256) * D * 2; }
    __device__ __forceinline__ unsigned a_rowoff(const pg8::Unit& u, int r) const { const unsigned pos = (unsigned)u.pm * 256u + (unsigned)r - base[u.aux];
        const int tok = pos < cnt[u.aux] ? list[(size_t)u.aux * MT + pos] : 0; return (unsigned)tok * (D * 2); }
};
struct EpiMoe1T { bf16_t* H;
    __device__ __forceinline__ void operator()(const f32x4 (&acc)[2][2][4][2], const pg8::Unit& u, int wr, int wc, int fr, int fq) const {
#pragma unroll
        for (int ai = 0; ai < 2; ++ai)
#pragma unroll
            for (int m = 0; m < 4; ++m)
#pragma unroll
                for (int n = 0; n < 2; ++n) { const f32x4 a = acc[ai][0][m][n], b = acc[ai][1][m][n];
                    st4bf(H + (size_t)(u.pm * 256 + ai * 128 + wr * 64 + m * 16 + fr) * EFF + u.pn * 128 + wc * 32 + n * 16 + 4 * fq, (f32x4){siluf_(a.x) * b.x, siluf_(a.y) * b.y, siluf_(a.z) * b.z, siluf_(a.w) * b.w}); } } };
struct SchedMoe2 {
    pg8::TileOrder o; const char* H; const char* W; const unsigned* base;
    __device__ __forceinline__ bool next(int i, pg8::Unit& u) const { if (!o.tile(i, u.pm, u.pn)) return false; u.aux = nv::moe_expert_of(base, (unsigned)u.pm * 256u); return true; }
    __device__ __forceinline__ const char* a_base(const pg8::Unit& u) const { return H + (size_t)u.pm * 256 * EFF * 2; }
    __device__ __forceinline__ const char* b_base(const pg8::Unit& u) const { return W + ((size_t)u.aux * 1024 + (size_t)u.pn * 256) * EFF * 2; }
    __device__ __forceinline__ unsigned a_rowoff(const pg8::Unit&, int r) const { return (unsigned)r * (EFF * 2); }
};
struct EpiYStore { bf16_t* Y; __device__ __forceinline__ void operator()(int row, int col0, f32x4 v) const { st4bf(Y + (size_t)row * D + col0, v); } };
struct EpiMoe2T { EpiYStore e; __device__ __forceinline__ void operator()(const f32x4 (&acc)[2][2][4][2], const pg8::Unit& u, int wr, int wc, int fr, int fq) const { pg8::epi_elems(acc, u.pm * 256, u.pn * 256, wr, wc, fr, fq, e); } };

__device__ __forceinline__ void fast_gemm_in(int tid, char* lds, const Ptrs& p, int l, int g, int bid, int G) {
    SchedIn S; S.init(p.h + (size_t)g * GR * D, win_t(p, l), G, bid, l == DEPTH - 1 ? 1 : 0);
    EpiInT E; E.e.P = p.P; E.e.rot = p.rot;
    pg8::gemm_phase<EpiInT, SchedIn, true>(tid, (PG8_LAS unsigned char*)lds, S, E, D);
}
__device__ __forceinline__ void fast_merge(int tid, char* lds, const Ptrs& p, int l, int Mrows, int bid, int G) {
    SchedMerge S; S.o.init(Mrows / 256, D / 256, G, bid); S.P = (const char*)p.P; S.Ba = (const char*)wproj_t(p, l, 0); S.Bb = (const char*)wproj_t(p, l, 1);
    EpiMergeT E; E.P = p.P;
    pg8::gemm_phase<EpiMergeT, SchedMerge, true>(tid, (PG8_LAS unsigned char*)lds, S, E, D);
}
__device__ __forceinline__ void fast_out(int tid, char* lds, const Ptrs& p, int l, int g, int Mrows, int bid, int G) {
    SchedOut S; S.o.init(Mrows / 256, D / 256, G, bid); S.P = (const char*)p.P; S.B = (const char*)wproj_t(p, l, 2);
    EpiOutT E; E.e.xsrc = l == 0 ? p.x : p.out; E.e.csrc = l == 0 ? p.ctx : p.cres; E.e.xdst = p.out; E.e.cdst = p.cres; E.e.mod_l = p.mod + (size_t)l * 9 * 6144; E.e.g = g;
    pg8::gemm_phase<EpiOutT, SchedOut, true>(tid, (PG8_LAS unsigned char*)lds, S, E, D);
}
__device__ __forceinline__ void fast_moe1(int tid, char* lds, const Ptrs& p, const unsigned* cnt, const unsigned* lbase, int bid, int G) {
    SchedMoe1 S; S.o.init((int)(lbase[NEXP] >> 8), 4, G, bid); S.h2 = (const char*)p.h; S.W = (const char*)w13_t(p); S.cnt = cnt; S.base = lbase; S.list = p.list;
    EpiMoe1T E; E.H = (bf16_t*)(p.ws + WS_MOEH);
    pg8::gemm_phase<EpiMoe1T, SchedMoe1, true>(tid, (PG8_LAS unsigned char*)lds, S, E, D);
}
__device__ __forceinline__ void fast_moe2(int tid, char* lds, const Ptrs& p, const unsigned* lbase, int bid, int G) {
    SchedMoe2 S; S.o.init((int)(lbase[NEXP] >> 8), 4, G, bid); S.H = (const char*)(p.ws + WS_MOEH); S.W = (const char*)w2_t(p); S.base = lbase;
    EpiMoe2T E; E.e.Y = (bf16_t*)(p.ws + WS_MOEY);
    pg8::gemm_phase<EpiMoe2T, SchedMoe2, true>(tid, (PG8_LAS unsigned char*)lds, S, E, EFF);
}
typedef short v4i16_t __attribute__((ext_vector_type(4)));
typedef float f32x16 __attribute__((ext_vector_type(16)));
#define MFMA32(a, b, c) __builtin_amdgcn_mfma_f32_32x32x16_bf16((a), (b), (c), 0, 0, 0)
__device__ __forceinline__ int crow16(int reg, int h) { return (reg & 3) + 8 * (reg >> 2) + 4 * h; }
__device__ __forceinline__ bf16x8 tr_frag(const LAS char* img, int rs, int r0, int c0, int lane) {
    const int h = lane >> 5, blk = (lane >> 4) & 1, q = (lane & 15) >> 2, p = lane & 3;
    const LAS char* a = img + (r0 + 8 * h + q) * rs + (c0 + 16 * blk + 4 * p) * 2;
    const v4i16_t lo = __builtin_amdgcn_ds_read_tr16_b64_v4i16((LAS v4i16_t*)a);
    const v4i16_t hi = __builtin_amdgcn_ds_read_tr16_b64_v4i16((LAS v4i16_t*)(a + 4 * rs));
    return (bf16x8){lo[0], lo[1], lo[2], lo[3], hi[0], hi[1], hi[2], hi[3]};
}
__device__ __forceinline__ bf16x8 row_frag(const LAS char* img, int rs, int r0, int k0, int lane) {
    return *(const LAS bf16x8*)(img + (r0 + (lane & 31)) * rs + (k0 + 8 * (lane >> 5)) * 2);
}
__device__ __forceinline__ u32x4 pack8(const float (&v)[8]) { u32x4 o; o.x = pk2(v[0], v[1]); o.y = pk2(v[2], v[3]); o.z = pk2(v[4], v[5]); o.w = pk2(v[6], v[7]); return o; }
__device__ __forceinline__ void unpack8(u32x4 w, float (&v)[8]) {
    v[0] = __uint_as_float(w.x << 16); v[1] = __uint_as_float(w.x & 0xffff0000u); v[2] = __uint_as_float(w.y << 16); v[3] = __uint_as_float(w.y & 0xffff0000u);
    v[4] = __uint_as_float(w.z << 16); v[5] = __uint_as_float(w.z & 0xffff0000u); v[6] = __uint_as_float(w.w << 16); v[7] = __uint_as_float(w.w & 0xffff0000u); }

__device__ __forceinline__ int chunk_row0(int c) {
    return c < GB * 32 ? (c >> 5) * SEQ + (c & 31) * CH : GX + ((c - GB * 32) >> 1) * CTXL + ((c - GB * 32) & 1) * CH;
}

constexpr int SG_MU = 0, SG_RS = 512, SG_VN = 1024, SG_VNS = 272, SG_OUT = 36864, SG_OUTS = 528;
__device__ __forceinline__ void fast_sgu_unit(int tid, char* lds_, int c, bf16_t* P, const bf16_t* wsb  , const float* b_s_l, const float* g_sgu_l) {
    LAS char* lds = (LAS char*)lds_;
    LAS float* mu = (LAS float*)(lds + SG_MU); LAS float* rs = (LAS float*)(lds + SG_RS);
    const int lane = tid & 63, wv = __builtin_amdgcn_readfirstlane(tid >> 6), row0 = chunk_row0(c);
    __syncthreads();
    for (int r = wv * 16; r < wv * 16 + 16; ++r) {
        const bf16_t* src = P + (size_t)(row0 + r) * DIN + C_VA; float s = 0.f, s2 = 0.f;
#pragma unroll
        for (int j = 0; j < 2; ++j) { float x[8]; unpack8(*(const u32x4*)(src + lane * 8 + 512 * j), x);
#pragma unroll
            for (int i = 0; i < 8; ++i) { s += x[i]; s2 += x[i] * x[i]; } }
        s = wave_sum(s); s2 = wave_sum(s2);
        const float m = s * (1.0f / 1024.0f), var = s2 * (1.0f / 1024.0f) - m * m;
        if (lane == 0) { mu[r] = m; rs[r] = 1.0f / sqrtf(fmaxf(var, 0.f) + EPS); }
    }
    const int pb = wv & 3, chf = wv >> 2, h = lane >> 5;
    for (int g = 0; g < 8; ++g) {
        __syncthreads();
#pragma unroll
        for (int i = 0; i < 4; ++i) { const int it = tid + 512 * i, q = it >> 4, c8 = (it & 15) * 8;
            float x[8]; unpack8(*(const u32x4*)(P + (size_t)(row0 + q) * DIN + C_VA + g * 128 + c8), x);
            const float m = mu[q], r = rs[q]; const f32x4 g0 = *(const f32x4*)(g_sgu_l + g * 128 + c8), g1 = *(const f32x4*)(g_sgu_l + g * 128 + c8 + 4);
            x[0] = (x[0] - m) * r * g0.x; x[1] = (x[1] - m) * r * g0.y; x[2] = (x[2] - m) * r * g0.z; x[3] = (x[3] - m) * r * g0.w;
            x[4] = (x[4] - m) * r * g1.x; x[5] = (x[5] - m) * r * g1.y; x[6] = (x[6] - m) * r * g1.z; x[7] = (x[7] - m) * r * g1.w;
            *(LAS u32x4*)(lds + SG_VN + q * SG_VNS + c8 * 2) = pack8(x); }
        bf16x8 af[8];
#pragma unroll
        for (int ks = 0; ks < 8; ++ks) af[ks] = *(const bf16x8*)(wsb + ((size_t)(g * 128 + pb * 32 + (lane & 31))) * 128 + ks * 16 + 8 * h);
        __syncthreads();
        f32x16 acc[2];
#pragma unroll
        for (int cb = 0; cb < 2; ++cb) { acc[cb] = (f32x16){};
#pragma unroll
            for (int ks = 0; ks < 8; ++ks) acc[cb] = MFMA32(af[ks], tr_frag(lds + SG_VN, SG_VNS, ks * 16, (chf * 2 + cb) * 32, lane), acc[cb]); }
#pragma unroll
        for (int cb = 0; cb < 2; ++cb)
#pragma unroll
            for (int r = 0; r < 16; ++r) *(LAS float*)(lds + SG_OUT + (pb * 32 + crow16(r, h)) * SG_OUTS + ((chf * 2 + cb) * 32 + (lane & 31)) * 4) = acc[cb][r];
        __syncthreads();
#pragma unroll
        for (int i = 0; i < 4; ++i) { const int it = tid + 512 * i, pp = it >> 4, c8 = (it & 15) * 8;
            const f32x4 o0 = *(const LAS f32x4*)(lds + SG_OUT + pp * SG_OUTS + c8 * 4), o1 = *(const LAS f32x4*)(lds + SG_OUT + pp * SG_OUTS + c8 * 4 + 16);
            bf16_t* up = P + (size_t)(row0 + pp) * DIN + C_U + g * 128 + c8; float x[8]; unpack8(*(const u32x4*)up, x);
            const float bs = b_s_l[g * 128 + pp];
            x[0] *= o0.x + bs; x[1] *= o0.y + bs; x[2] *= o0.z + bs; x[3] *= o0.w + bs; x[4] *= o1.x + bs; x[5] *= o1.y + bs; x[6] *= o1.z + bs; x[7] *= o1.w + bs;
            *(u32x4*)up = pack8(x); }
    }
}

constexpr int NCI = 34;
__device__ __forceinline__ int ret_row0(int lb, int ci) { return ci < 2 ? GX + lb * CTXL + ci * CH : lb * SEQ + (ci - 2) * CH; }
__device__ __forceinline__ bf16_t* kv_slot(bf16_t* KV, int lbh, int ci, int dir) { return KV + ((size_t)((lbh * NCI + ci) * 2 + dir)) * 32768; }
__device__ __forceinline__ float log_sigmoid_(float x) { return -log1pf(expf(-x)); }

constexpr int R1_KF = 0, R1_KB = 34816, R1_V = 69632, R_KS = 272, R_VS = 528;
__device__ __forceinline__ void ret_kv_unit(int tid, char* lds_, int lb, int hh, int ci, const bf16_t* P, bf16_t* KV, const float* decay_l) {
    LAS char* lds = (LAS char*)lds_;
    const int lane = tid & 63, wv = __builtin_amdgcn_readfirstlane(tid >> 6), row0 = ret_row0(lb, ci), h = lane >> 5;
    const float lgf = log_sigmoid_(decay_l[hh]), lgb = log_sigmoid_(decay_l[4 + hh]);
    __syncthreads();
#pragma unroll
    for (int i = 0; i < 4; ++i) { const int it = tid + 512 * i, j = it >> 4, d8 = (it & 15) * 8;
        float x[8], y[8]; unpack8(*(const u32x4*)(P + (size_t)(row0 + j) * DIN + C_K + hh * DK + d8), x);
        const float ff = __expf(lgf * (float)(127 - j)), fb = __expf(lgb * (float)j);
#pragma unroll
        for (int u = 0; u < 8; ++u) { y[u] = x[u] * fb; x[u] *= ff; }
        *(LAS u32x4*)(lds + R1_KF + j * R_KS + d8 * 2) = pack8(x); *(LAS u32x4*)(lds + R1_KB + j * R_KS + d8 * 2) = pack8(y); }
#pragma unroll
    for (int i = 0; i < 8; ++i) { const int it = tid + 512 * i, j = it >> 5, e8 = (it & 31) * 8;
        *(LAS u32x4*)(lds + R1_V + j * R_VS + e8 * 2) = *(const u32x4*)(P + (size_t)(row0 + j) * DIN + C_V + hh * DV + e8); }
    __syncthreads();
    const int dir = wv >> 2, dblk = wv & 3;
    bf16x8 af[8];
#pragma unroll
    for (int ks = 0; ks < 8; ++ks) af[ks] = tr_frag(lds + (dir ? R1_KB : R1_KF), R_KS, ks * 16, dblk * 32, lane);
    bf16_t* dst = kv_slot(KV, lb * 4 + hh, ci, dir);
#pragma unroll 2
    for (int eb = 0; eb < 8; ++eb) {
        f32x16 acc = (f32x16){};
#pragma unroll
        for (int ks = 0; ks < 8; ++ks) acc = MFMA32(af[ks], tr_frag(lds + R1_V, R_VS, ks * 16, eb * 32, lane), acc);
#pragma unroll
        for (int gq = 0; gq < 4; ++gq) { u32x2 o; o.x = pk2(acc[4 * gq], acc[4 * gq + 1]); o.y = pk2(acc[4 * gq + 2], acc[4 * gq + 3]);
            *(u32x2*)(dst + ((size_t)((8 * dblk + 2 * gq + h) * 256 + eb * 32 + (lane & 31))) * 4) = o; }
    }
}

template <int DIR> __device__ __forceinline__ void ret_scan_strip(bf16_t* base  , float cdec) {
    float st[8];
#pragma unroll
    for (int u = 0; u < 8; ++u) { st[u] = 0.f; asm volatile("" : "+v"(st[u])); }
#pragma unroll
    for (int half = 0; half < 2; ++half) {
        u32x4 val[NCI / 2];
#pragma unroll
        for (int q = 0; q < NCI / 2; ++q) { const int s = half * (NCI / 2) + q; const int ci = DIR == 0 ? s : (s == 0 ? 1 : s == 1 ? 0 : NCI + 1 - s);
            val[q] = *(const u32x4*)(base + (size_t)ci * 2 * 32768); }
#pragma unroll
        for (int q = 0; q < NCI / 2; ++q) { const int s = half * (NCI / 2) + q; const int ci = DIR == 0 ? s : (s == 0 ? 1 : s == 1 ? 0 : NCI + 1 - s);
            float x[8]; unpack8(val[q], x);
            *(u32x4*)(base + (size_t)ci * 2 * 32768) = pack8(st);
#pragma unroll
            for (int u = 0; u < 8; ++u) st[u] = cdec * st[u] + x[u]; }
    }
}
__device__ __forceinline__ void ret_scan(int tid, bf16_t* KV, const float* decay_l, int bid, int G) {
    for (int s = bid * 512 + tid; s < GB * NHEAD * 2 * 4096; s += G * 512) {
        const int chain = s >> 12, el = (s & 4095) * 8, lbh = chain >> 1, dir = chain & 1, hh = lbh & 3;
        const float cdec = __expf(128.0f * log_sigmoid_(decay_l[dir * 4 + hh]));
        bf16_t* base = kv_slot(KV, lbh, 0, dir) + el;
        if (dir == 0) ret_scan_strip<0>(base, cdec); else ret_scan_strip<1>(base, cdec);
    }
}

constexpr int R3_Q = 0, R3_K = 34816, R3_V = 69632, R3_ZS = 1040;
__device__ __forceinline__ void ret_out_unit(int tid, char* lds_, int lb, int hh, int ci, bf16_t* P, const bf16_t* KV, const float* decay_l) {
    LAS char* lds = (LAS char*)lds_;
    const int lane = tid & 63, wv = __builtin_amdgcn_readfirstlane(tid >> 6), row0 = ret_row0(lb, ci), h = lane >> 5, r31 = lane & 31;
    const float lgf = log_sigmoid_(decay_l[hh]), lgb = log_sigmoid_(decay_l[4 + hh]);
    __syncthreads();
#pragma unroll
    for (int i = 0; i < 4; ++i) { const int it = tid + 512 * i, j = it >> 4, d8 = (it & 15) * 8; const bf16_t* src = P + (size_t)(row0 + j) * DIN + hh * DK + d8;
        *(LAS u32x4*)(lds + R3_Q + j * R_KS + d8 * 2) = *(const u32x4*)(src + C_Q); *(LAS u32x4*)(lds + R3_K + j * R_KS + d8 * 2) = *(const u32x4*)(src + C_K); }
#pragma unroll
    for (int i = 0; i < 8; ++i) { const int it = tid + 512 * i, j = it >> 5, e8 = (it & 31) * 8;
        *(LAS u32x4*)(lds + R3_V + j * R_VS + e8 * 2) = *(const u32x4*)(P + (size_t)(row0 + j) * DIN + C_V + hh * DV + e8); }
    bf16x8 sf[8];
    const int ecol = wv * 32 + r31;
#define LOAD_STATE(dst, dirv) do { const bf16_t* s0_ = kv_slot((bf16_t*)KV, lb * 4 + hh, ci, dirv); \
      _Pragma("unroll") for (int ks = 0; ks < 8; ++ks) { const size_t o_ = ((size_t)((4 * ks + 2 * h) * 256 + ecol)) * 4; \
          const u32x2 a0_ = *(const u32x2*)(s0_ + o_), a1_ = *(const u32x2*)(s0_ + o_ + 1024); dst[ks] = __builtin_bit_cast(bf16x8, (u32x4){a0_.x, a0_.y, a1_.x, a1_.y}); } } while (0)
    LOAD_STATE(sf, 0);
    __syncthreads();
    u32x2 pk[2][4];
#pragma unroll
    for (int tt = 0; tt < 2; ++tt) { const int T = wv * 2 + tt, mt = T >> 2, nb = T & 3;
        f32x16 x = (f32x16){};
#pragma unroll
        for (int ks = 0; ks < 8; ++ks) x = MFMA32(row_frag(lds + R3_K, R_KS, mt * 32, ks * 16, lane), row_frag(lds + R3_Q, R_KS, nb * 32, ks * 16, lane), x);
        int hq = h; asm volatile("" : "+v"(hq));
        const int n = nb * 32 + r31;
#pragma unroll
        for (int r = 0; r < 16; ++r) { const int m = mt * 32 + crow16(r, hq); x[r] *= (m <= n) ? __expf(lgf * (float)(n - m)) : __expf(lgb * (float)(m - n)); }
#pragma unroll
        for (int gq = 0; gq < 4; ++gq) { pk[tt][gq].x = pk2(x[4 * gq], x[4 * gq + 1]); pk[tt][gq].y = pk2(x[4 * gq + 2], x[4 * gq + 3]); } }
    __syncthreads();
#pragma unroll
    for (int tt = 0; tt < 2; ++tt) { const int T = wv * 2 + tt, mt = T >> 2, nb = T & 3;
#pragma unroll
        for (int gq = 0; gq < 4; ++gq) *(LAS u32x2*)(lds + R3_K + (nb * 32 + r31) * R_KS + (mt * 32 + 8 * gq + 4 * h) * 2) = pk[tt][gq]; }
    __syncthreads();
    f32x16 z[4];
    bf16x8 sb[8];
    LOAD_STATE(sb, 1);
#pragma unroll
    for (int nb = 0; nb < 4; ++nb) {
        f32x16 t1 = (f32x16){};
#pragma unroll
        for (int ks = 0; ks < 8; ++ks) t1 = MFMA32(row_frag(lds + R3_Q, R_KS, nb * 32, ks * 16, lane), sf[ks], t1);
        { int hq = h; asm volatile("" : "+v"(hq));
#pragma unroll
          for (int r = 0; r < 16; ++r) t1[r] *= __expf(lgf * (float)(nb * 32 + crow16(r, hq) + 1)); }
        z[nb] = t1;
    }
#pragma unroll
    for (int nb = 0; nb < 4; ++nb) {
        f32x16 t2 = (f32x16){};
#pragma unroll
        for (int ks = 0; ks < 8; ++ks) t2 = MFMA32(row_frag(lds + R3_Q, R_KS, nb * 32, ks * 16, lane), sb[ks], t2);
        { int hq = h; asm volatile("" : "+v"(hq));
#pragma unroll
          for (int r = 0; r < 16; ++r) z[nb][r] += t2[r] * __expf(lgb * (float)(128 - (nb * 32 + crow16(r, hq)))); }
    }
    {
        bf16x8 vf[8];
#pragma unroll
        for (int ks = 0; ks < 8; ++ks) vf[ks] = tr_frag(lds + R3_V, R_VS, ks * 16, wv * 32, lane);
#pragma unroll
        for (int nb = 0; nb < 4; ++nb)
#pragma unroll
            for (int ks = 0; ks < 8; ++ks) z[nb] = MFMA32(row_frag(lds + R3_K, R_KS, nb * 32, ks * 16, lane), vf[ks], z[nb]);
    }
#undef LOAD_STATE
    __syncthreads();
#pragma unroll
    for (int nb = 0; nb < 4; ++nb)
#pragma unroll
        for (int r = 0; r < 16; ++r) *(LAS float*)(lds + (nb * 32 + crow16(r, h)) * R3_ZS + (wv * 32 + r31) * 4) = z[nb][r];
    __syncthreads();
    for (int n = wv * 16; n < wv * 16 + 16; ++n) {
        const f32x4 v = *(const LAS f32x4*)(lds + n * R3_ZS + lane * 16);
        const float s = wave_sum((v.x + v.y) + (v.z + v.w)), s2 = wave_sum((v.x * v.x + v.y * v.y) + (v.z * v.z + v.w * v.w));
        const float mean = s * (1.0f / 256.0f), rstd = 1.0f / sqrtf(fmaxf(s2 * (1.0f / 256.0f) - mean * mean, 0.f) + EPS);
        bf16_t* gp = P + (size_t)(row0 + n) * DIN + C_GR + hh * DV + lane * 4;
        st4bf(gp, ld4bf(gp) * ((v - mean) * rstd));
    }
}
constexpr int PH_PER_LAYER = 16, N_PRO = 2, N_PHASES = N_PRO + DEPTH * PH_PER_LAYER;
struct Args { const float* in[24]; float* out; unsigned char* ws; int ph_lo, ph_hi; };

#ifndef FAST_GEMM_IN
#define FAST_GEMM_IN 0
#endif
#ifndef FAST_MERGE
#define FAST_MERGE 0
#endif
#ifndef FAST_OUT
#define FAST_OUT 0
#endif
#ifndef FAST_MOE
#define FAST_MOE 0
#endif
#ifndef FAST_SGU
#define FAST_SGU 0
#endif
#ifndef FAST_RET
#define FAST_RET 0
#endif

#define TID_HERE const int tid = ({ int t_ = threadIdx.x; asm volatile("" : "+v"(t_)); t_; })
__global__ void __launch_bounds__(NWAVES * 64, 2) mega(Args args) {
    extern __shared__ __attribute__((aligned(16))) unsigned char lds_raw[];
    char* lds = (char*)lds_raw;
    const int G = gridDim.x, bid = blockIdx.x;
    const Ptrs p = make_ptrs((void* const*)args.in, args.out, args.ws);
    for (int u = threadIdx.x; u < (LDS_BYTES - LDSCTL_OFF) / 4; u += NWAVES * 64) ((LAS unsigned*)(lds_raw + LDSCTL_OFF))[u] = 0u;
    __syncthreads();
    unsigned* lbase = (unsigned*)(lds + LDS_BASE_OFF);
    XcdBarrier bar = xcd_barrier_post(p.ctl + CW_BAR, (volatile LAS unsigned*)(lds_raw + LDS_MISC_OFF) + 8);

    for (int ph = args.ph_lo; ph < args.ph_hi; ++ph) {
        if (ph == 0) {
            TID_HERE;
            for (int vb = bid; vb < 192; vb += G) nv::b_mod(tid, lds, vb, p.c, p.c_ctx, p.w_ada, p.b_ada, p.mod);
            for (int vb = bid; vb < SEQ * 64 / 512; vb += G) nv::b_rot(tid, vb, p.rot);
            fast_prologue(tid, lds, p, bid, G);
        } else if (ph == 1) {
            TID_HERE;
            for (int vb = bid; vb < MT / 8; vb += G) nv::b_norm1(tid, vb, p.x, p.ctx, p.g_mix, p.mod, p.h);
        } else {
            const int q = ph - N_PRO, l = q / PH_PER_LAYER, r = q % PH_PER_LAYER;
            const float* mod_l = p.mod + (size_t)l * 9 * 6144;
            if (r < 12) {
                const int g = r / 6, st = r % 6;
                const int Mrows = l == 0 ? GR : GX;
                if (st == 0) {
                    TID_HERE;
#if FAST_GEMM_IN
                    fast_gemm_in(tid, lds, p, l, g, bid, G);
#else
                    nv::FDense<EpiIn> f{}; f.A = p.h + (size_t)g * GR * D; f.lda = D; f.B = p.w_in + (size_t)l * D * DIN; f.ldb_ = DIN; f.K_ = D; f.e.P = p.P; f.e.rot = p.rot;
                    for (int vb = bid; vb < (DIN / 64) * (GR / 128); vb += G) nv::b_gemm(tid, lds, vb % (DIN / 64), vb / (DIN / 64), f);
#endif
                } else if (st == 1) {
                    TID_HERE;
                    const int chunks = GB * 32 + (l == 0 ? GB * 2 : 0);
#if FAST_SGU
                    for (int vb = bid; vb < chunks; vb += G) fast_sgu_unit(tid, lds, vb, p.P, ws_b(p, l), p.b_s + l * 8 * 128, p.g_sgu + l * 1024);
#else
                    for (int vb = bid; vb < chunks * 8; vb += G) nv::b_sgu(tid, lds, vb >> 3, vb & 7, p.P, p.w_s + (size_t)l * 8 * 128 * 128, p.b_s + l * 8 * 128, p.g_sgu + l * 1024);
#endif
#if FAST_RET
                    for (int vb = bid; vb < GB * NHEAD * NCI; vb += G) ret_kv_unit(tid, lds, vb / (NHEAD * NCI), (vb / NCI) % NHEAD, vb % NCI, p.P, p.KV, p.decay + l * 8);
#endif
                } else if (st == 2) {
                    TID_HERE; (void)tid;
#if FAST_RET
                    ret_scan(tid, p.KV, p.decay + l * 8, bid, G);
#endif
#if FAST_MOE
                    if (l == 1 && g == 0) conv_moe(tid, lds, p, 1, bid, G);
#endif
                } else if (st == 3) {
                    TID_HERE;
#if FAST_RET
                    { const int c0 = l == 0 ? 0 : 2, nper = NCI - c0;
                      for (int vb = bid; vb < GB * NHEAD * nper; vb += G) ret_out_unit(tid, lds, vb / (NHEAD * nper), (vb / nper) % NHEAD, c0 + vb % nper, p.P, p.KV, p.decay + l * 8); }
#else
                    for (int vb = bid; vb < (SEQ / 32) * NHEAD * GB; vb += G) nv::b_ret(tid, lds, vb % (SEQ / 32), (vb / (SEQ / 32)) % NHEAD, vb / ((SEQ / 32) * NHEAD), p.P, p.decay + l * 8, 0);
                    if (l == 0) for (int vb = bid; vb < (CTXL / 32) * NHEAD * GB; vb += G) nv::b_ret(tid, lds, vb % (CTXL / 32), (vb / (CTXL / 32)) % NHEAD, vb / ((CTXL / 32) * NHEAD), p.P, p.decay + l * 8, 1);
#endif
                } else if (st == 4) {
                    TID_HERE;
#if FAST_MERGE
                    fast_merge(tid, lds, p, l, Mrows, bid, G);
#else
                    nv::FDense<EpiMergeA> fa{}; fa.A = p.P + C_U; fa.lda = DIN; fa.B = p.w_pa + (size_t)l * D * D; fa.ldb_ = D; fa.K_ = D; fa.e.P = p.P;
                    nv::FDense<EpiMergeB> fb{}; fb.A = p.P + C_GR; fb.lda = DIN; fb.B = p.w_pb + (size_t)l * D * D; fb.ldb_ = D; fb.K_ = D; fb.e.P = p.P;
                    for (int vb = bid; vb < (D / 64) * (Mrows / 128); vb += G) { nv::b_gemm(tid, lds, vb % (D / 64), vb / (D / 64), fa); nv::b_gemm(tid, lds, vb % (D / 64), vb / (D / 64), fb); }
#endif
                } else {
                    TID_HERE;
#if FAST_OUT
                    fast_out(tid, lds, p, l, g, Mrows, bid, G);
#else
                    nv::FDense<EpiOut> f{}; f.A = p.P + C_GA; f.lda = DIN; f.B = p.w_out + (size_t)l * D * D; f.ldb_ = D; f.K_ = D;
                    f.e.xsrc = l == 0 ? p.x : p.out; f.e.csrc = l == 0 ? p.ctx : p.cres; f.e.xdst = p.out; f.e.cdst = p.cres; f.e.mod_l = mod_l; f.e.g = g;
                    for (int vb = bid; vb < (D / 64) * (Mrows / 128); vb += G) nv::b_gemm(tid, lds, vb % (D / 64), vb / (D / 64), f);
#endif
                }
            } else {
                const int st = r - 12;
                unsigned* cnt = p.ctl + CW_CNT + l * 32;
                bf16_t* Hb = (bf16_t*)(p.ws + WS_MOEH); float* G1 = (float*)(p.ws + WS_MOEY); bf16_t* Y = (bf16_t*)(p.ws + WS_MOEY);
                if (st == 0) {
                    TID_HERE;
                    norm2_phase(tid, lds, bid, G, p.out, p.cres, p.g_ffn + l * D, mod_l, p.h, p.w_group + l * D * 4, p.b_group + l * 4, p.w_er + l * D * 32, p.b_er + l * 32, cnt, p.tok_e, p.tok_p, p.tok_w, p.list, l == 0 ? 1 : 0);
                } else if (st == 1) {
                    TID_HERE;
                    nv::b_offsets(tid, cnt, lbase);
#if FAST_MOE
                    fast_moe1(tid, lds, p, cnt, lbase, bid, G);
#else
                    nv::MoeCtx m{cnt, lbase, p.list};
                    nv::FMoe1 f1{}; f1.m = m; f1.h2 = p.h; f1.W = p.w1 + (size_t)l * NEXP * D * EFF; f1.G1 = G1; f1.Hout = Hb; f1.second = 0;
                    nv::FMoe1 f3 = f1; f3.W = p.w3 + (size_t)l * NEXP * D * EFF; f3.second = 1;
                    for (int vb = bid; vb < (EFF / 64) * (SLOT_CAP / 128); vb += G) { nv::b_gemm(tid, lds, vb % (EFF / 64), vb / (EFF / 64), f1); nv::b_gemm(tid, lds, vb % (EFF / 64), vb / (EFF / 64), f3); }
#endif
                } else if (st == 2) {
                    TID_HERE;
                    nv::b_offsets(tid, cnt, lbase);
#if FAST_MOE
                    fast_moe2(tid, lds, p, lbase, bid, G);
#else
                    nv::MoeCtx m{cnt, lbase, p.list};
                    nv::FMoe2 f2{}; f2.m = m; f2.Hin = Hb; f2.W = p.w2 + (size_t)l * NEXP * EFF * D; f2.Y = Y;
                    for (int vb = bid; vb < (D / 64) * (SLOT_CAP / 128); vb += G) nv::b_gemm(tid, lds, vb % (D / 64), vb / (D / 64), f2);
#endif
                } else {
                    TID_HERE;
                    nv::b_offsets(tid, cnt, lbase);
                    const int last = (l == DEPTH - 1);
                    for (int vb = bid; vb < MT / 8; vb += G)
                        nv::b_combine(tid, vb, p.out, p.cres, Y, lbase, p.tok_e, p.tok_p, p.tok_w, mod_l, l == 0 ? 1 : 0, last, last ? p.g_mix : p.g_mix + (l + 1) * D, last ? p.mod : p.mod + (size_t)(l + 1) * 9 * 6144, p.h, p.g_final);
                }
            }
        }
        if (ph + 1 < args.ph_hi) xcd_barrier(bar);
    }
}

extern "C" void kernel_launch(void* const* d_in, const int* in_sizes, int n_in, void* d_out, int out_size, void* d_ws, size_t ws_size, hipStream_t stream) {
    static int grid = 0;
    if (grid == 0) {
        if (n_in != 24 || out_size != TX * D || ws_size < WS_END) { fprintf(stderr, "kernel_launch: unexpected sizes n_in %d out %d ws %zu\n", n_in, out_size, ws_size); grid = -1; return; }
        int dev = 0, cus = 0, per_cu = 0;
        if (hipGetDevice(&dev) != hipSuccess || hipDeviceGetAttribute(&cus, hipDeviceAttributeMultiprocessorCount, dev) != hipSuccess) { grid = -1; return; }
        if (hipFuncSetAttribute((const void*)mega, hipFuncAttributeMaxDynamicSharedMemorySize, LDS_BYTES) != hipSuccess) { fprintf(stderr, "kernel_launch: hipFuncSetAttribute failed\n"); grid = -1; return; }
        if (hipOccupancyMaxActiveBlocksPerMultiprocessor(&per_cu, (const void*)mega, NWAVES * 64, LDS_BYTES) != hipSuccess || per_cu < 1) fprintf(stderr, "kernel_launch: occupancy query says %d\n", per_cu);
        (void)hipGetLastError();
        grid = cus;
    }
    if (grid < 0) return;
    (void)hipMemsetAsync((char*)d_ws + WS_CTL, 0, CTL_BYTES, stream);
    Args a{};
    for (int i = 0; i < 24; ++i) a.in[i] = (const float*)d_in[i];
    a.out = (float*)d_out; a.ws = (unsigned char*)d_ws;
#ifndef N_LAUNCH_SPLIT
    a.ph_lo = 0; a.ph_hi = N_PHASES;
    hipLaunchKernelGGL(mega, dim3(grid), dim3(NWAVES * 64), LDS_BYTES, stream, a);
#else
    for (int ph = 0; ph < N_PHASES; ++ph) { a.ph_lo = ph; a.ph_hi = ph + 1; hipLaunchKernelGGL(mega, dim3(grid), dim3(NWAVES * 64), LDS_BYTES, stream, a); }
#endif
}
```
